# Optimizing an MI355X kernel written in HIP

```python
import jax, jax.numpy as jnp
from jax import lax
import numpy as np

D_MODEL = 1024
BATCH = 4
SEQ = 8192
DEPTH = 2

GRID_W = 64
CTX_LEN = 256
EPS = 1e-6
ROPE_BASE = 10000.0
NEG_INF = -1e30

D_MIX = D_MODEL
GROUP_W = D_MIX // 4
MLA_HEADS = 4
MLA_NOPE = 64
MLA_ROPE = 32
MLA_V = GROUP_W // MLA_HEADS
MLA_Q_RANK = D_MODEL // 4
MLA_KV_RANK = D_MODEL // 8
Q_BLOCK = 128
FN_W = GROUP_W
FN_GROUPS = 4
NA_HEADS = 4
NA_HD = GROUP_W // NA_HEADS
NA_WIN_H = 8
NA_WIN_W = 16
NA_QCOL = 16
NA_KCOL = NA_QCOL + NA_WIN_W
CV_W = GROUP_W
CV_K = 31
D_FF = 4 * D_MODEL

IN_WIDTHS = (MLA_Q_RANK, MLA_KV_RANK, MLA_ROPE, GROUP_W, GROUP_W, GROUP_W, FN_W, 2 * CV_W)
D_IN = MLA_Q_RANK + MLA_KV_RANK + MLA_ROPE + 3 * GROUP_W + FN_W + 2 * CV_W

kernel_name = "hybrid_mla_fnet_natten_conformer_dit"


def rmsnorm(x, g):
    xf = x.astype(jnp.float32)
    y = xf * lax.rsqrt(jnp.mean(xf * xf, axis=-1, keepdims=True) + EPS)
    return (y * g.astype(jnp.float32)).astype(x.dtype)


def layernorm(x, g, b):
    xf = x.astype(jnp.float32)
    mu = jnp.mean(xf, axis=-1, keepdims=True)
    var = jnp.mean(jnp.square(xf - mu), axis=-1, keepdims=True)
    y = (xf - mu) * lax.rsqrt(var + EPS)
    return (y * g.astype(jnp.float32) + b.astype(jnp.float32)).astype(x.dtype)


def modulate(h, shift, scale):
    return h * (1 + scale[:, None, :]) + shift[:, None, :]


def axial_rope(n, dim):
    t = jnp.arange(n)
    row = (t // GRID_W).astype(jnp.float32)
    col = (t % GRID_W).astype(jnp.float32)
    per_axis = dim // 2
    inv = ROPE_BASE ** (-jnp.arange(0, per_axis, 2, dtype=jnp.float32) / per_axis)
    ang = jnp.concatenate([row[:, None] * inv, col[:, None] * inv], axis=-1)
    return jnp.cos(ang), jnp.sin(ang)


def apply_rope(x, cos, sin):
    half = x.shape[-1] // 2
    xf = x.astype(jnp.float32)
    x1, x2 = xf[..., :half], xf[..., half:]
    return jnp.concatenate([x1 * cos - x2 * sin, x1 * sin + x2 * cos], axis=-1).astype(x.dtype)


def attend(q, k, v):
    s = jnp.einsum('bqhd,bkhd->bhqk', q, k).astype(jnp.float32) * (q.shape[-1] ** -0.5)
    w = jax.nn.softmax(s, axis=-1).astype(v.dtype)
    return jnp.einsum('bhqk,bkhd->bqhd', w, v)


def mla_q(q_a, q_norm, w_uq, rope):
    B, L, _ = q_a.shape
    q = (rmsnorm(q_a, q_norm) @ w_uq).reshape(B, L, MLA_HEADS, MLA_NOPE + MLA_ROPE)
    if rope is not None:
        cos, sin = rope
        q = jnp.concatenate([q[..., :MLA_NOPE], apply_rope(q[..., MLA_NOPE:], cos[:, None], sin[:, None])], axis=-1)
    return q


def mla_kv(kv_a, k_r, kv_norm, w_ukv, rope):
    B, L, _ = kv_a.shape
    kv = (rmsnorm(kv_a, kv_norm) @ w_ukv).reshape(B, L, MLA_HEADS, MLA_NOPE + MLA_V)
    if rope is not None:
        cos, sin = rope
        k_r = apply_rope(k_r, cos, sin)
    k_r = jnp.broadcast_to(k_r[:, :, None, :], (B, L, MLA_HEADS, MLA_ROPE))
    k = jnp.concatenate([kv[..., :MLA_NOPE], k_r], axis=-1)
    return k, kv[..., MLA_NOPE:]


def mla_latent(q, k, v, kc, vc):
    B, S, H, d = q.shape
    k_all = jnp.concatenate([k, kc], axis=1)
    v_all = jnp.concatenate([v, vc], axis=1)
    qb = q.reshape(B, S // Q_BLOCK, Q_BLOCK, H, d).transpose(1, 0, 2, 3, 4)
    ob = lax.map(lambda qi: attend(qi, k_all, v_all), qb)
    return ob.transpose(1, 0, 2, 3, 4).reshape(B, S, H * MLA_V)


def natten_cols():
    n_cb = GRID_W // NA_QCOL
    qcol = np.arange(GRID_W).reshape(n_cb, NA_QCOL)
    win_start = np.clip(qcol - NA_WIN_W // 2, 0, GRID_W - NA_WIN_W)
    blk_start = np.clip(np.arange(n_cb) * NA_QCOL - NA_WIN_W // 2, 0, GRID_W - NA_KCOL)
    kcol = blk_start[:, None] + np.arange(NA_KCOL)
    ws = win_start[:, :, None]
    in_win = (kcol[:, None, :] >= ws) & (kcol[:, None, :] < ws + NA_WIN_W)
    rel_idx = np.clip(kcol[:, None, :] - qcol[:, :, None] + NA_WIN_W - 1, 0, 2 * NA_WIN_W - 2)
    return kcol, in_win, rel_idx


def natten_latent(q, k, v, kc, vc, rpb):
    B, S, H, d = q.shape
    rows = S // GRID_W
    wh = min(NA_WIN_H, rows)
    n_cb = GRID_W // NA_QCOL
    kcol, in_win, rel_idx = natten_cols()
    qg = q.reshape(B, rows, n_cb, NA_QCOL, H, d)
    kg = k.reshape(B, rows, GRID_W, H, d)[:, :, kcol]
    vg = v.reshape(B, rows, GRID_W, H, d)[:, :, kcol]
    rpb = rpb.astype(jnp.float32)
    scale = d ** -0.5
    n_loc = wh * NA_KCOL

    def row_block(r):
        rs = jnp.clip(r - wh // 2, 0, rows - wh)
        kb = lax.dynamic_slice_in_dim(kg, rs, wh, axis=1)
        vb = lax.dynamic_slice_in_dim(vg, rs, wh, axis=1)
        qr = lax.dynamic_index_in_dim(qg, r, axis=1, keepdims=False)
        dr_idx = rs + jnp.arange(wh) - r + (NA_WIN_H - 1)
        bias = rpb[:, dr_idx][:, :, rel_idx].transpose(0, 2, 3, 1, 4)
        bias = jnp.where(in_win[:, :, None, :], bias, NEG_INF)
        s_loc = jnp.einsum('bcqhd,bwckhd->bhcqwk', qr, kb).astype(jnp.float32) * scale + bias[None]
        s_ctx = jnp.einsum('bcqhd,bkhd->bhcqk', qr, kc).astype(jnp.float32) * scale
        s = jnp.concatenate([s_loc.reshape(B, H, n_cb, NA_QCOL, n_loc), s_ctx], axis=-1)
        w = jax.nn.softmax(s, axis=-1).astype(v.dtype)
        w_loc = w[..., :n_loc].reshape(B, H, n_cb, NA_QCOL, wh, NA_KCOL)
        return (jnp.einsum('bhcqwk,bwckhd->bcqhd', w_loc, vb)
                + jnp.einsum('bhcqk,bkhd->bcqhd', w[..., n_loc:], vc))

    o = lax.map(row_block, jnp.arange(rows))
    return o.transpose(1, 0, 2, 3, 4, 5).reshape(B, S, H * d)


def heads(u, n_heads):
    B, L, W = u.shape
    return u.reshape(B, L, n_heads, W // n_heads)


def fourier_mix(u):
    B, L, W = u.shape
    ug = u.reshape(B, L, FN_GROUPS, W // FN_GROUPS).astype(jnp.float32)
    f = jnp.fft.fft2(ug, axes=(1, 3), norm='ortho').real
    return f.reshape(B, L, W).astype(u.dtype)


def conformer_conv(u, w_dw, b_dw, ln_g, ln_b):
    a, g = jnp.split(u, 2, axis=-1)
    y = a * jax.nn.sigmoid(g)
    y = lax.conv_general_dilated(y, w_dw[:, None, :], window_strides=(1,),
                                 padding=[(CV_K // 2, CV_K // 2)],
                                 dimension_numbers=('NWC', 'WIO', 'NWC'),
                                 feature_group_count=CV_W) + b_dw
    y = layernorm(y, ln_g, ln_b)
    return jax.nn.silu(y)


def sq_relu_mlp(h, w1, w2):
    return jnp.square(jax.nn.relu(h @ w1)) @ w2


def split_cols(p):
    return jnp.split(p, np.cumsum(IN_WIDTHS)[:-1].tolist(), axis=-1)


def trunk_layer(x, xc, mod_x, mod_c, rope, prm, last):
    (w_in, q_norm, w_uq, kv_norm, w_ukv, rpb, cv_w, cv_b, cv_g, cv_beta,
     w_out, g1, g2, w1, w2) = prm
    sh1, sc1, gt1, sh2, sc2, gt2 = jnp.split(mod_x, 6, axis=-1)
    csh1, csc1, cgt1, csh2, csc2, cgt2 = jnp.split(mod_c, 6, axis=-1)

    h = modulate(rmsnorm(x, g1), sh1, sc1)
    hc = modulate(rmsnorm(xc, g1), csh1, csc1)
    q_a, kv_a, k_r, na_q, na_k, na_v, fn_u, cv_u = split_cols(h @ w_in)
    cq_a, ckv_a, ck_r, cna_q, cna_k, cna_v, cfn_u, ccv_u = split_cols(hc @ w_in)

    mk_c, mv_c = mla_kv(ckv_a, ck_r, kv_norm, w_ukv, None)
    nk_c, nv_c = heads(cna_k, NA_HEADS), heads(cna_v, NA_HEADS)

    mq = mla_q(q_a, q_norm, w_uq, rope)
    mk, mv = mla_kv(kv_a, k_r, kv_norm, w_ukv, rope)
    o_mla = mla_latent(mq, mk, mv, mk_c, mv_c)
    o_na = natten_latent(heads(na_q, NA_HEADS), heads(na_k, NA_HEADS), heads(na_v, NA_HEADS), nk_c, nv_c, rpb)
    o_fn = fourier_mix(fn_u)
    o_cv = conformer_conv(cv_u, cv_w, cv_b, cv_g, cv_beta)
    y = jnp.concatenate([o_mla, o_na, o_fn, o_cv], axis=-1) @ w_out
    x = x + gt1[:, None, :] * y
    x = x + gt2[:, None, :] * sq_relu_mlp(modulate(rmsnorm(x, g2), sh2, sc2), w1, w2)

    if not last:
        B, C, _ = hc.shape
        o_mla_c = attend(mla_q(cq_a, q_norm, w_uq, None), mk_c, mv_c).reshape(B, C, MLA_HEADS * MLA_V)
        o_na_c = attend(heads(cna_q, NA_HEADS), nk_c, nv_c).reshape(B, C, GROUP_W)
        yc = jnp.concatenate([o_mla_c, o_na_c, fourier_mix(cfn_u),
                              conformer_conv(ccv_u, cv_w, cv_b, cv_g, cv_beta)], axis=-1) @ w_out
        xc = xc + cgt1[:, None, :] * yc
        xc = xc + cgt2[:, None, :] * sq_relu_mlp(modulate(rmsnorm(xc, g2), csh2, csc2), w1, w2)
    return x, xc


def setup_inputs(seed: int = 0) -> dict:
    key = jax.random.key(seed)
    ks = iter(jax.random.split(key, 32))

    def nrm(shape, scale):
        return jax.random.normal(next(ks), shape, jnp.float32) * scale

    def gain(shape):
        return 1.0 + nrm(shape, 0.05)

    L = DEPTH
    return {
        "x": nrm((BATCH, SEQ, D_MODEL), 1.0),
        "c": nrm((BATCH, D_MODEL), 1.0),
        "ctx": nrm((BATCH, CTX_LEN, D_MODEL), 1.0),
        "c_ctx": nrm((D_MODEL,), 1.0),
        "w_mod": nrm((L, D_MODEL, 6 * D_MODEL), 0.5 * D_MODEL ** -0.5),
        "b_mod": nrm((L, 6 * D_MODEL), 0.01),
        "norm1_g": gain((L, D_MODEL)),
        "norm2_g": gain((L, D_MODEL)),
        "w_in": nrm((L, D_MODEL, D_IN), D_MODEL ** -0.5),
        "mla_q_norm": gain((L, MLA_Q_RANK)),
        "mla_w_uq": nrm((L, MLA_Q_RANK, MLA_HEADS * (MLA_NOPE + MLA_ROPE)), MLA_Q_RANK ** -0.5),
        "mla_kv_norm": gain((L, MLA_KV_RANK)),
        "mla_w_ukv": nrm((L, MLA_KV_RANK, MLA_HEADS * (MLA_NOPE + MLA_V)), MLA_KV_RANK ** -0.5),
        "na_rpb": nrm((L, NA_HEADS, 2 * NA_WIN_H - 1, 2 * NA_WIN_W - 1), 0.5),
        "cv_w_dw": nrm((L, CV_K, CV_W), CV_K ** -0.5),
        "cv_b_dw": nrm((L, CV_W), 0.01),
        "cv_ln_g": gain((L, CV_W)),
        "cv_ln_b": nrm((L, CV_W), 0.01),
        "w_out": nrm((L, D_MIX, D_MODEL), D_MIX ** -0.5),
        "w_ff1": nrm((L, D_MODEL, D_FF), D_MODEL ** -0.5),
        "w_ff2": nrm((L, D_FF, D_MODEL), D_FF ** -0.5),
        "final_g": gain((D_MODEL,)),
    }


def reference(x, c, ctx, c_ctx, w_mod, b_mod, norm1_g, norm2_g, w_in, mla_q_norm, mla_w_uq,
              mla_kv_norm, mla_w_ukv, na_rpb, cv_w_dw, cv_b_dw, cv_ln_g, cv_ln_b, w_out,
              w_ff1, w_ff2, final_g):
    rope = axial_rope(x.shape[1], MLA_ROPE)
    xc = ctx
    for i in range(DEPTH):
        mod_x = jax.nn.silu(c) @ w_mod[i] + b_mod[i]
        mod_c = jax.nn.silu(c_ctx)[None, :] @ w_mod[i] + b_mod[i]
        prm = (w_in[i], mla_q_norm[i], mla_w_uq[i], mla_kv_norm[i], mla_w_ukv[i], na_rpb[i],
               cv_w_dw[i], cv_b_dw[i], cv_ln_g[i], cv_ln_b[i], w_out[i],
               norm1_g[i], norm2_g[i], w_ff1[i], w_ff2[i])
        x, xc = trunk_layer(x, xc, mod_x, mod_c, rope, prm, i == DEPTH - 1)
    return rmsnorm(x, final_g)
```

```cpp
#include <hip/hip_runtime.h>
#include <hip/hip_cooperative_groups.h>
#include <hip/hip_bf16.h>
#include <cstdio>
#include <cstdint>
namespace cg = cooperative_groups;

#ifndef PROBE_PART
#define PROBE_PART 0
#endif
#ifndef MK_MULTI
#define MK_MULTI 0
#endif

constexpr int DM = 1024, NBATCH = 4, SEQ = 8192, CTXL = 256, DEPTH = 2, DFF = 4096;
constexpr int ML = NBATCH * SEQ, MC = NBATCH * CTXL, MT = ML + MC;
constexpr int D_IN = 1952;
constexpr int NP = 2304;
constexpr int PC_QA = 0, PC_KVA = 256, PC_KR = 384, PC_NAQ = 416, PC_NAK = 672, PC_NAV = 928, PC_ZR = 1184, PC_ZI = 1440, PC_CV = 1696;
constexpr float EPS = 1e-6f;
constexpr int MODW = 6 * DM;

constexpr size_t MiB = 1u << 20;
constexpr size_t WS_MOD = 0;
constexpr size_t WS_ROPE = 248 * 1024;
constexpr size_t WS_B1 = 256 * 1024;
constexpr size_t WS_B2 = 352 * 1024;
constexpr size_t WS_STAT = 512 * 1024;
#define STATP(ws, l, w) ((float*)((ws) + WS_STAT) + (size_t)((l) * 4 + (w)) * MT)
constexpr size_t WS_BAR = 1792 * 1024;
constexpr size_t WS_WIN = 2 * MiB;
constexpr size_t WS_WUQ = 11 * MiB;
constexpr size_t WS_WUKV = 11 * MiB + 512 * 1024;
constexpr size_t WS_WOUT = 12 * MiB;
constexpr size_t WS_W1 = 16 * MiB;
constexpr size_t WS_W2 = 32 * MiB;
constexpr size_t WS_XC = 48 * MiB;
constexpr size_t WS_XN = 52 * MiB;
constexpr size_t WS_Y = 118 * MiB;
constexpr size_t WS_H = 150 * MiB;
constexpr size_t WS_P = 150 * MiB;
constexpr size_t WS_Q = 299 * MiB;
constexpr size_t WS_K = 324 * MiB;
constexpr size_t WS_V = 349 * MiB;
constexpr size_t WS_O = 366 * MiB;
constexpr size_t WS_XR = 432 * MiB;
constexpr size_t WS_END = 496 * MiB;

__device__ __forceinline__ int fresh_tid() { int t = threadIdx.x; asm volatile("" : "+v"(t)); return t; }
namespace pg8 {
#define PG8_LAS __attribute__((address_space(3)))
typedef unsigned short bf16_t;
typedef short bf16x8 __attribute__((ext_vector_type(8)));
typedef float f32x4 __attribute__((ext_vector_type(4)));
typedef float f32x2 __attribute__((ext_vector_type(2)));
typedef unsigned u32x4 __attribute__((ext_vector_type(4)));
typedef unsigned u32x2 __attribute__((ext_vector_type(2)));
constexpr int BM = 256, BK = 64, HALF = 128, HTB = HALF * BK * 2, STAGE_BYTES = 8 * HTB, NXCD = 8, WGM = 8;

__host__ __device__ __forceinline__ int lds_byte(int r, int c) { const int st = (r >> 4) * 2 + (c >> 5), rr = r & 15, cc = c & 31, ob = rr * 64 + cc * 2; return st * 1024 + (ob ^ (((ob >> 9) & 1) << 5)); }
__host__ __device__ __forceinline__ void stage_rc(int b, int& R, int& C) { const int st = b / 1024, sb = b % 1024, swz = sb ^ (((sb >> 9) & 1) << 5); R = (st >> 1) * 16 + swz / 64; C = (st & 1) * 32 + (swz % 64) / 2; }
__host__ __device__ __forceinline__ int perm32(int rho) { const int n = rho >> 4, i = rho & 15; return 8 * (i >> 2) + 4 * n + (i & 3); }

struct Unit { int pm, pn; };
struct Gemm { const bf16_t* A; const bf16_t* Bt; };

struct StaticOrder {
    int nM, nN, nwg, G, c;
    __host__ __device__ void init(int M, int N, int G_, int c_) { nM = M / BM; nN = N / BM; nwg = nM * nN; G = G_; c = c_; }
    __host__ __device__ bool next(int i, Unit& u) const {
        const long L = (long)i * G + c; if (L >= nwg) return false;
        int wgid = (int)L; { const int q = nwg / NXCD, r = nwg % NXCD, xcd = wgid % NXCD, off = wgid / NXCD; wgid = (xcd < r ? xcd * (q + 1) : r * (q + 1) + (xcd - r) * q) + off; }
        const int nig = WGM * nN, gid = wgid / nig, fm = gid * WGM, gsz = (nM - fm) < WGM ? (nM - fm) : WGM;
        u.pm = fm + ((wgid % nig) % gsz); u.pn = (wgid % nig) / gsz; return true;
    }
};

__device__ __forceinline__ unsigned cvt_pk_bf16(float lo, float hi) { unsigned r; asm volatile("v_cvt_pk_bf16_f32 %0, %1, %2" : "=v"(r) : "v"(lo), "v"(hi)); return r; }

template <class Epi, bool ALIGN_EPI, int K, int LDA, int LDB>
__device__ __forceinline__ void gemm_phase(PG8_LAS unsigned char* lds, const Gemm g, const StaticOrder& S, const Epi& E) {
    const int tid = fresh_tid(), wid = __builtin_amdgcn_readfirstlane(tid >> 6), lane = tid & 63, wr = wid >> 2, wc = wid & 3, fr = lane & 15, fq = lane >> 4;
    constexpr int nt = K / BK;
    unsigned voffA[2], voffB[2];
#pragma unroll
    for (int i = 0; i < 2; ++i) { int R, C; stage_rc(tid * 16 + i * 8192, R, C); const int Rb = Epi::PERM ? ((R & ~31) + perm32(R & 31)) : R;
        voffA[i] = (unsigned)(R * LDA + C) * 2u; voffB[i] = (unsigned)(Rb * LDB + C) * 2u; }
    constexpr size_t kstep = (size_t)(BK * 2);
    constexpr size_t hstepA = (size_t)HALF * LDA * 2, hstepB = (size_t)HALF * LDB * 2;
    constexpr size_t tstepA = 2 * hstepA, tstepB = 2 * hstepB;
    const unsigned ldsw = (unsigned)wid * 1024u;
    const int aoff = lds_byte(wr * 64 + fr, fq * 8), boff = lds_byte(wc * 32 + fr, fq * 8);
#define PG8_SA(b, h) (((b) * 2 + (h)) * HTB)
#define PG8_SB(b, h) ((4 + (b) * 2 + (h)) * HTB)
#define PG8_STAGE(bufoff, gbase, voff) do { _Pragma("unroll") for (int _i = 0; _i < 2; ++_i) \
        __builtin_amdgcn_global_load_lds((const unsigned*)((const char*)(gbase) + (voff)[_i]), (PG8_LAS unsigned*)(lds + (bufoff) + ldsw + _i * 8192), 16, 0, 0); } while (0)
#define PG8_LDA(dst, b, h) do { _Pragma("unroll") for (int m = 0; m < 4; ++m) _Pragma("unroll") for (int k = 0; k < 2; ++k) dst[m][k] = *(const PG8_LAS bf16x8*)(lds + PG8_SA(b, h) + aoff + m * 2048 + k * 1024); } while (0)
#define PG8_LDB(dst, b, h) do { _Pragma("unroll") for (int n = 0; n < 2; ++n) _Pragma("unroll") for (int k = 0; k < 2; ++k) dst[n][k] = *(const PG8_LAS bf16x8*)(lds + PG8_SB(b, h) + boff + n * 2048 + k * 1024); } while (0)
#define PG8_MMA(ai, bj, At, Bt) do { __builtin_amdgcn_s_setprio(1); _Pragma("unroll") for (int m = 0; m < 4; ++m) _Pragma("unroll") for (int n = 0; n < 2; ++n) _Pragma("unroll") for (int k = 0; k < 2; ++k) \
        acc[ai][bj][m][n] = __builtin_amdgcn_mfma_f32_16x16x32_bf16(Bt[n][k], At[m][k], acc[ai][bj][m][n], 0, 0, 0); __builtin_amdgcn_s_setprio(0); } while (0)
#define PG8_WAIT_V(n) asm volatile("s_waitcnt vmcnt(" #n ")" ::: "memory")
#define PG8_WAIT_L(n) asm volatile("s_waitcnt lgkmcnt(" #n ")" ::: "memory")
#define PG8_BAR __builtin_amdgcn_s_barrier()
#define PG8_SCHED __builtin_amdgcn_sched_barrier(0)
    Unit cur, nxt; int ui = 0;
    if (!S.next(0, cur)) return;
    f32x4 acc[2][2][4][2];
#pragma unroll
    for (int a = 0; a < 2; ++a)
#pragma unroll
        for (int b = 0; b < 2; ++b)
#pragma unroll
            for (int m = 0; m < 4; ++m)
#pragma unroll
                for (int n = 0; n < 2; ++n) acc[a][b][m][n] = (f32x4){0.f, 0.f, 0.f, 0.f};
    bf16x8 At[4][2], B0[2][2], B1[2][2];
    const char* cA = (const char*)g.A + (size_t)cur.pm * tstepA; const char* cB = (const char*)g.Bt + (size_t)cur.pn * tstepB;
    PG8_STAGE(PG8_SB(0, 0), cB, voffB); PG8_STAGE(PG8_SB(0, 1), cB + hstepB, voffB); PG8_STAGE(PG8_SA(0, 0), cA, voffA); PG8_STAGE(PG8_SA(0, 1), cA + hstepA, voffA);
    if (wr == 1) PG8_BAR;
    PG8_WAIT_V(2); PG8_BAR;
    PG8_STAGE(PG8_SB(1, 0), cB + kstep, voffB); PG8_STAGE(PG8_SA(1, 0), cA + kstep, voffA); PG8_STAGE(PG8_SB(1, 1), cB + hstepB + kstep, voffB);
    PG8_WAIT_V(6); PG8_BAR;
    for (;;) {
        const bool has_next = S.next(ui + 1, nxt);
        const char* nA = has_next ? (const char*)g.A + (size_t)nxt.pm * tstepA : cA; const char* nB = has_next ? (const char*)g.Bt + (size_t)nxt.pn * tstepB : cB;
#pragma unroll 1
        for (int t = 0; t < nt; t += 2) {
            const bool last = (t == nt - 2);
            const char* a1 = cA + (size_t)(t + 1) * kstep;
            const char* a2 = last ? nA : cA + (size_t)(t + 2) * kstep; const char* b2 = last ? nB : cB + (size_t)(t + 2) * kstep;
            const char* a3 = a2 + kstep; const char* b3 = b2 + kstep;
            PG8_LDB(B0, 0, 0); PG8_LDB(B1, 0, 1); PG8_SCHED; PG8_LDA(At, 0, 0); PG8_STAGE(PG8_SA(1, 1), a1 + hstepA, voffA);
            PG8_WAIT_V(8); PG8_WAIT_L(0); PG8_BAR; PG8_MMA(0, 0, At, B0); PG8_MMA(0, 1, At, B1); PG8_BAR; PG8_SCHED;
            PG8_LDA(At, 0, 1); PG8_STAGE(PG8_SB(0, 0), b2, voffB); PG8_STAGE(PG8_SB(0, 1), b2 + hstepB, voffB); PG8_STAGE(PG8_SA(0, 0), a2, voffA);
            PG8_WAIT_V(8); PG8_WAIT_L(0); PG8_BAR; PG8_MMA(1, 0, At, B0); PG8_MMA(1, 1, At, B1); PG8_BAR; PG8_SCHED;
            PG8_LDB(B0, 1, 0); PG8_LDB(B1, 1, 1); PG8_SCHED; PG8_LDA(At, 1, 0); PG8_STAGE(PG8_SA(0, 1), a2 + hstepA, voffA);
            PG8_WAIT_V(8); PG8_WAIT_L(0); PG8_BAR; PG8_MMA(0, 0, At, B0); PG8_MMA(0, 1, At, B1); PG8_BAR; PG8_SCHED;
            PG8_LDA(At, 1, 1); PG8_STAGE(PG8_SB(1, 0), b3, voffB); PG8_STAGE(PG8_SB(1, 1), b3 + hstepB, voffB); PG8_STAGE(PG8_SA(1, 0), a3, voffA);
            PG8_WAIT_V(8); PG8_WAIT_L(0); PG8_BAR; PG8_MMA(1, 0, At, B0); PG8_MMA(1, 1, At, B1); PG8_BAR; PG8_SCHED;
        }
        if constexpr (ALIGN_EPI) { if (wr == 0) PG8_BAR; }
        E(acc, cur, wr, wc, fr, fq);
        if (!has_next) break;
#pragma unroll
        for (int a = 0; a < 2; ++a)
#pragma unroll
            for (int b = 0; b < 2; ++b)
#pragma unroll
                for (int m = 0; m < 4; ++m)
#pragma unroll
                    for (int n = 0; n < 2; ++n) acc[a][b][m][n] = (f32x4){0.f, 0.f, 0.f, 0.f};
        cur = nxt; cA = nA; cB = nB; ++ui;
        if constexpr (ALIGN_EPI) { if (wr == 1) PG8_BAR; }
    }
    PG8_WAIT_V(0);
    if constexpr (!ALIGN_EPI) { if (wr == 0) PG8_BAR; }
    PG8_BAR;
#undef PG8_SA
#undef PG8_SB
#undef PG8_STAGE
#undef PG8_LDA
#undef PG8_LDB
#undef PG8_MMA
#undef PG8_WAIT_V
#undef PG8_WAIT_L
#undef PG8_BAR
#undef PG8_SCHED
}

__device__ __forceinline__ u32x2 pack4(f32x4 v) { u32x2 w; w.x = cvt_pk_bf16(v[0], v[1]); w.y = cvt_pk_bf16(v[2], v[3]); return w; }

struct EpiWin {
    static constexpr bool PERM = false;
    bf16_t* P; bf16_t* Kb; float* ssq; float* sskv; const float* rope; const float* ss1; const float* bias1;
    __device__ __forceinline__ void operator()(const f32x4 (&acc0)[2][2][4][2], const Unit& u, int wr, int wc, int fr, int fq) const {
        const int row0 = u.pm * BM + wr * 64 + fr, colb = u.pn * BM + wc * 32 + 4 * fq;
        const int s = (u.pm < 128) ? (u.pm >> 5) : 4;
        f32x4 bv[2][2];
#pragma unroll
        for (int bj = 0; bj < 2; ++bj)
#pragma unroll
            for (int n = 0; n < 2; ++n) bv[bj][n] = *(const f32x4*)(bias1 + s * NP + colb + bj * HALF + n * 16);
        float rrv[8], ssv[8];
#pragma unroll
        for (int q = 0; q < 8; ++q) { rrv[q] = ss1[row0 + (q >> 2) * HALF + (q & 3) * 16]; ssv[q] = 0.f; }
#pragma unroll
        for (int ai = 0; ai < 2; ++ai)
#pragma unroll
            for (int m = 0; m < 4; ++m) {
                const int row = row0 + ai * HALF + m * 16;
                const float rr = 1.0f / sqrtf(rrv[ai * 4 + m] * (1.0f / DM) + EPS);
                f32x4 acc[2][2][4][2];
#pragma unroll
                for (int bj = 0; bj < 2; ++bj)
#pragma unroll
                    for (int n = 0; n < 2; ++n) acc[ai][bj][m][n] = acc0[ai][bj][m][n] * rr + bv[bj][n];
                bf16_t* rp = P + (size_t)row * NP + colb;
#pragma unroll
                for (int bj = 0; bj < 2; ++bj)
#pragma unroll
                    for (int n = 0; n < 2; ++n) *(u32x2*)(rp + bj * HALF + n * 16) = pack4(acc[ai][bj][m][n]);
                if (u.pn == 0) {
                    float ss = 0.f;
#pragma unroll
                    for (int bj = 0; bj < 2; ++bj)
#pragma unroll
                        for (int n = 0; n < 2; ++n) { const f32x4 v = acc[ai][bj][m][n]; ss += (v[0] * v[0] + v[1] * v[1]) + (v[2] * v[2] + v[3] * v[3]); }
                    ssv[ai * 4 + m] = ss;
                } else if (u.pn == 1) {
                    float ss = 0.f;
#pragma unroll
                    for (int n = 0; n < 2; ++n) { const f32x4 v = acc[ai][0][m][n]; ss += (v[0] * v[0] + v[1] * v[1]) + (v[2] * v[2] + v[3] * v[3]); }
                    ssv[ai * 4 + m] = ss;
                    if (wc == 0) {
                        f32x4 x1 = acc[ai][1][m][0], x2 = acc[ai][1][m][1];
                        if (u.pm < 128) {
                            const int tok = row & (SEQ - 1), pos = (fq < 2) ? (tok >> 6) : (tok & 63);
                            const f32x4 t0 = *(const f32x4*)(rope + pos * 16 + 8 * (fq & 1)), t1 = *(const f32x4*)(rope + pos * 16 + 8 * (fq & 1) + 4);
                            const f32x4 cs = {t0[0], t0[2], t1[0], t1[2]}, sn = {t0[1], t0[3], t1[1], t1[3]};
                            const f32x4 o1 = x1 * cs - x2 * sn, o2 = x1 * sn + x2 * cs; x1 = o1; x2 = o2;
                        }
                        const u32x2 w1 = pack4(x1), w2 = pack4(x2);
#pragma unroll
                        for (int h = 0; h < 4; ++h) { bf16_t* kp = Kb + (size_t)row * 384 + h * 96 + 64 + 4 * fq; *(u32x2*)kp = w1; *(u32x2*)(kp + 16) = w2; }
                    }
                }
            }
        if (u.pn < 2) { float* sp = (u.pn == 0) ? ssq : sskv;
#pragma unroll
            for (int q = 0; q < 8; ++q) { float ss = ssv[q]; ss += __shfl_xor(ss, 16); ss += __shfl_xor(ss, 32); if (fq == 0) atomicAdd(sp + row0 + (q >> 2) * HALF + (q & 3) * 16, ss); } }
    }
};
struct EpiQ {
    static constexpr bool PERM = false;
    bf16_t* Q; const float* ssq; const float* rope;
    __device__ __forceinline__ void operator()(const f32x4 (&acc)[2][2][4][2], const Unit& u, int wr, int wc, int fr, int fq) const {
        const int row0 = u.pm * BM + wr * 64 + fr;
        float rrv[8];
#pragma unroll
        for (int q = 0; q < 8; ++q) rrv[q] = ssq[row0 + (q >> 2) * HALF + (q & 3) * 16];
#pragma unroll
        for (int ai = 0; ai < 2; ++ai)
#pragma unroll
            for (int m = 0; m < 4; ++m) {
                const int row = row0 + ai * HALF + m * 16;
                const float r = 1.0f / sqrtf(rrv[ai * 4 + m] * (1.0f / 256.0f) + EPS);
#pragma unroll
                for (int bj = 0; bj < 2; ++bj) {
                    const int blk = u.pn * 8 + bj * 4 + wc;
                    if (blk < 12) {
                        f32x4 x1 = acc[ai][bj][m][0] * r, x2 = acc[ai][bj][m][1] * r;
                        if ((blk % 3) == 2 && u.pm < 128) {
                            const int tok = row & (SEQ - 1), pos = (fq < 2) ? (tok >> 6) : (tok & 63);
                            const f32x4 t0 = *(const f32x4*)(rope + pos * 16 + 8 * (fq & 1)), t1 = *(const f32x4*)(rope + pos * 16 + 8 * (fq & 1) + 4);
                            const f32x4 cs = {t0[0], t0[2], t1[0], t1[2]}, sn = {t0[1], t0[3], t1[1], t1[3]};
                            const f32x4 o1 = x1 * cs - x2 * sn, o2 = x1 * sn + x2 * cs; x1 = o1; x2 = o2;
                        }
                        bf16_t* qp = Q + (size_t)row * 384 + blk * 32 + 4 * fq;
                        *(u32x2*)qp = pack4(x1); *(u32x2*)(qp + 16) = pack4(x2);
                    }
                }
            }
    }
};
struct EpiKV {
    static constexpr bool PERM = false;
    bf16_t* Kb; bf16_t* Vb; const float* sskv;
    __device__ __forceinline__ void operator()(const f32x4 (&acc)[2][2][4][2], const Unit& u, int wr, int wc, int fr, int fq) const {
        const int row0 = u.pm * BM + wr * 64 + fr;
        float rrv[8];
#pragma unroll
        for (int q = 0; q < 8; ++q) rrv[q] = sskv[row0 + (q >> 2) * HALF + (q & 3) * 16];
#pragma unroll
        for (int ai = 0; ai < 2; ++ai)
#pragma unroll
            for (int m = 0; m < 4; ++m) {
                const int row = row0 + ai * HALF + m * 16;
                const float r = 1.0f / sqrtf(rrv[ai * 4 + m] * (1.0f / 128.0f) + EPS);
#pragma unroll
                for (int bj = 0; bj < 2; ++bj) {
                    const int blk = u.pn * 8 + bj * 4 + wc, h = blk >> 2, w0 = (blk & 3) * 32 + 4 * fq;
                    bf16_t* dp = (w0 < 64) ? (Kb + (size_t)row * 384 + h * 96 + w0) : (Vb + (size_t)row * 256 + h * 64 + (w0 - 64));
                    *(u32x2*)dp = pack4(acc[ai][bj][m][0] * r); *(u32x2*)(dp + 16) = pack4(acc[ai][bj][m][1] * r);
                }
            }
    }
};
template <bool IN_H> struct EpiRes {
    static constexpr bool PERM = false;
    const float* res_lat; const float* res_ctx; bf16_t* xr; float* out_ctx; const float* gate;
    bf16_t* XS; float* ssn; const float* gn; const float* scn;
    __device__ __forceinline__ void operator()(const f32x4 (&acc)[2][2][4][2], const Unit& u, int wr, int wc, int fr, int fq) const {
        const bool lat = IN_H || (u.pm < 128);
        const int s = (u.pm < 128) ? (u.pm >> 5) : 4;
        const int lrow0 = ((u.pm < 128) ? u.pm * BM : (u.pm - 128) * BM) + wr * 64 + fr;
        const int grow0 = u.pm * BM + wr * 64 + fr;
        const int col0 = u.pn * BM + wc * 32 + 4 * fq;
        f32x4 gv[2][2], gs[2][2];
#pragma unroll
        for (int bj = 0; bj < 2; ++bj)
#pragma unroll
            for (int n = 0; n < 2; ++n) { gv[bj][n] = *(const f32x4*)(gate + s * MODW + col0 + bj * HALF + n * 16);
                if (XS) gs[bj][n] = *(const f32x4*)(gn + col0 + bj * HALF + n * 16) * (*(const f32x4*)(scn + s * MODW + col0 + bj * HALF + n * 16) + 1.0f);
                else gs[bj][n] = (f32x4){0.f, 0.f, 0.f, 0.f}; }
        float ssv[8];
        constexpr int GRP = IN_H ? 4 : 2;
#pragma unroll
        for (int pr = 0; pr < 8 / GRP; ++pr) {
            f32x4 pre[IN_H ? 1 : GRP][2][2]; u32x2 preh[IN_H ? GRP : 1][2][2];
#pragma unroll
            for (int mm = 0; mm < GRP; ++mm) { const int q = pr * GRP + mm; const size_t off = (size_t)(lrow0 + (q >> 2) * HALF + (q & 3) * 16) * DM + col0;
#pragma unroll
                for (int bj = 0; bj < 2; ++bj)
#pragma unroll
                    for (int n = 0; n < 2; ++n) {
                        if constexpr (IN_H) preh[mm][bj][n] = *(const u32x2*)(xr + off + bj * HALF + n * 16);
                        else pre[mm][bj][n] = *(const f32x4*)((lat ? res_lat : res_ctx) + off + bj * HALF + n * 16); } }
#pragma unroll
            for (int mm = 0; mm < GRP; ++mm) { const int q = pr * GRP + mm, ai = q >> 2, m = q & 3;
                const size_t off = (size_t)(lrow0 + ai * HALF + m * 16) * DM + col0;
                const size_t goff = (size_t)(grow0 + ai * HALF + m * 16) * DM + col0;
                float ss = 0.f;
#pragma unroll
                for (int bj = 0; bj < 2; ++bj)
#pragma unroll
                    for (int n = 0; n < 2; ++n) { f32x4 rv;
                        if constexpr (IN_H) { const u32x2 w = preh[mm][bj][n]; rv = (f32x4){__builtin_bit_cast(float, w.x << 16), __builtin_bit_cast(float, w.x & 0xffff0000u), __builtin_bit_cast(float, w.y << 16), __builtin_bit_cast(float, w.y & 0xffff0000u)}; }
                        else rv = pre[mm][bj][n];
                        const f32x4 o = rv + gv[bj][n] * acc[ai][bj][m][n];
                        if (lat) *(u32x2*)(xr + off + bj * HALF + n * 16) = pack4(o); else *(f32x4*)(out_ctx + off + bj * HALF + n * 16) = o;
                        if (XS) { ss += (o[0] * o[0] + o[1] * o[1]) + (o[2] * o[2] + o[3] * o[3]); *(u32x2*)(XS + goff + bj * HALF + n * 16) = pack4(o * gs[bj][n]); } }
                ssv[q] = ss;
            }
            asm volatile("" ::: "memory");
        }
        if (XS) {
#pragma unroll
            for (int q = 0; q < 8; ++q) { float ss = ssv[q]; ss += __shfl_xor(ss, 16); ss += __shfl_xor(ss, 32); if (fq == 0) atomicAdd(ssn + grow0 + (q >> 2) * HALF + (q & 3) * 16, ss); } }
    }
};
struct EpiPart {
    static constexpr bool PERM = false;
    float* part;
    __device__ __forceinline__ void operator()(const f32x4 (&acc)[2][2][4][2], const Unit& u, int wr, int wc, int fr, int fq) const {
        const int lrow0 = u.pm * BM + wr * 64 + fr, col0 = u.pn * BM + wc * 32 + 4 * fq;
#pragma unroll
        for (int ai = 0; ai < 2; ++ai)
#pragma unroll
            for (int m = 0; m < 4; ++m) { float* op = part + (size_t)(lrow0 + ai * HALF + m * 16) * DM + col0;
#pragma unroll
                for (int bj = 0; bj < 2; ++bj)
#pragma unroll
                    for (int n = 0; n < 2; ++n) *(f32x4*)(op + bj * HALF + n * 16) = acc[ai][bj][m][n]; }
    }
};
struct EpiFF1 {
    static constexpr bool PERM = true;
    bf16_t* O; int ldc; const float* ss2; const float* bias2;
    __device__ __forceinline__ void operator()(const f32x4 (&acc)[2][2][4][2], const Unit& u, int wr, int wc, int fr, int fq) const {
        const int row0 = u.pm * BM + wr * 64 + fr, col0 = u.pn * BM + wc * 32 + 8 * fq;
        const int s = (u.pm < 128) ? (u.pm >> 5) : 4;
        f32x4 bv[2][2];
#pragma unroll
        for (int bj = 0; bj < 2; ++bj)
#pragma unroll
            for (int n = 0; n < 2; ++n) bv[bj][n] = *(const f32x4*)(bias2 + s * DFF + col0 + bj * HALF + 4 * n);
        float rrv[8];
#pragma unroll
        for (int q = 0; q < 8; ++q) rrv[q] = ss2[row0 + (q >> 2) * HALF + (q & 3) * 16];
#pragma unroll
        for (int ai = 0; ai < 2; ++ai)
#pragma unroll
            for (int m = 0; m < 4; ++m) { const int row = row0 + ai * HALF + m * 16; bf16_t* rowp = O + (size_t)row * ldc + col0;
                const float rr = 1.0f / sqrtf(rrv[ai * 4 + m] * (1.0f / DM) + EPS);
#pragma unroll
                for (int bj = 0; bj < 2; ++bj) { f32x4 v0 = acc[ai][bj][m][0] * rr + bv[bj][0], v1 = acc[ai][bj][m][1] * rr + bv[bj][1];
#pragma unroll
                    for (int j = 0; j < 4; ++j) { const float a = fmaxf(v0[j], 0.f), b = fmaxf(v1[j], 0.f); v0[j] = a * a; v1[j] = b * b; }
                    u32x4 w; w.x = cvt_pk_bf16(v0[0], v0[1]); w.y = cvt_pk_bf16(v0[2], v0[3]); w.z = cvt_pk_bf16(v1[0], v1[1]); w.w = cvt_pk_bf16(v1[2], v1[3]);
                    *(u32x4*)(rowp + bj * HALF) = w; } }
    }
};
}

namespace att {
using bf16x8 = __attribute__((ext_vector_type(8))) short;
using s16x4 = __attribute__((ext_vector_type(4))) short;
using f32x16 = __attribute__((ext_vector_type(16))) float;
using u32x4 = __attribute__((ext_vector_type(4))) unsigned;
typedef unsigned short bf16_t;
constexpr int NW = 8, QBLK = 32, KVBLK = 64;
constexpr float THR = 8.f;
constexpr size_t SHM_V = 16384, SHM_K = 16384, SHM_ATTN = 2 * SHM_V + 2 * SHM_K + NW * 64 * 4;
#define KSWZ(row, colB) ((row) * 256 + ((colB) ^ (((row) & 15) << 4)))
#define SBAR() __builtin_amdgcn_sched_barrier(0)
__device__ __forceinline__ int crow(int r, int hi) { return (r & 3) + 8 * (r >> 2) + 4 * hi; }
__device__ __forceinline__ unsigned cvtpk(float lo, float hi) { unsigned r; asm volatile("v_cvt_pk_bf16_f32 %0, %1, %2" : "=v"(r) : "v"(lo), "v"(hi)); return r; }
__device__ __forceinline__ bf16x8 ld8(const bf16_t* p) { return *reinterpret_cast<const bf16x8*>(p); }

template <int DQK> __device__ __forceinline__ void partialSM(f32x16& p0, f32x16& p1, float& m_reg, float& mn, float& alpha) {
  constexpr float SCALE = (DQK == 96) ? 0.10206207261596577f : 0.125f;
  constexpr float C = SCALE * 1.4426950408889634f;
  float pmax = p0[0];
#pragma unroll
  for (int r = 1; r < 16; ++r) pmax = fmaxf(pmax, p0[r]);
#pragma unroll
  for (int r = 0; r < 16; ++r) pmax = fmaxf(pmax, p1[r]);
  { auto rr = __builtin_amdgcn_permlane32_swap(__float_as_uint(pmax), __float_as_uint(pmax), false, false);
    pmax = fmaxf(__uint_as_float(rr[0]), __uint_as_float(rr[1])); }
  if (__builtin_expect(__all(pmax - m_reg <= THR / SCALE), 1)) { mn = m_reg; alpha = 1.f; }
  else { mn = fmaxf(m_reg, pmax); alpha = __builtin_amdgcn_exp2f((m_reg - mn) * C); m_reg = mn; }
  float mnC = -mn * C;
#pragma unroll
  for (int r = 0; r < 16; ++r) p0[r] = fmaf(p0[r], C, mnC);
#pragma unroll
  for (int r = 0; r < 16; ++r) p1[r] = fmaf(p1[r], C, mnC);
#pragma unroll
  for (int r = 0; r < 16; ++r) p0[r] = __builtin_amdgcn_exp2f(p0[r]);
}
__device__ __forceinline__ void finishSM(f32x16& p0, f32x16& p1, float alpha, float& l_reg, bf16x8& pa0, bf16x8& pa1, bf16x8& pa2, bf16x8& pa3) {
#pragma unroll
  for (int r = 0; r < 16; ++r) p1[r] = __builtin_amdgcn_exp2f(p1[r]);
  float ps = 0;
#pragma unroll
  for (int r = 0; r < 16; ++r) ps += p0[r];
#pragma unroll
  for (int r = 0; r < 16; ++r) ps += p1[r];
  { auto rr = __builtin_amdgcn_permlane32_swap(__float_as_uint(ps), __float_as_uint(ps), false, false);
    ps = __uint_as_float(rr[0]) + __uint_as_float(rr[1]); }
  l_reg = l_reg * alpha + ps;
#define PK4(P, BASE, OUT) do { unsigned a0 = cvtpk(P[BASE + 0], P[BASE + 1]), a1 = cvtpk(P[BASE + 2], P[BASE + 3]);   \
    unsigned b0 = cvtpk(P[BASE + 4], P[BASE + 5]), b1 = cvtpk(P[BASE + 6], P[BASE + 7]);                              \
    auto r0 = __builtin_amdgcn_permlane32_swap(a0, b0, false, false); auto r1 = __builtin_amdgcn_permlane32_swap(a1, b1, false, false); \
    u32x4 w = {r0[0], r1[0], r0[1], r1[1]}; OUT = *reinterpret_cast<bf16x8*>(&w); } while (0)
  PK4(p0, 0, pa0); PK4(p0, 8, pa1); PK4(p1, 0, pa2); PK4(p1, 8, pa3);
#undef PK4
}
template <int DQK> __device__ __forceinline__ void qkt(f32x16& p0, f32x16& p1, const char* Ks, const bf16x8* qr, int r32, int hi) {
  p0 = f32x16{}; p1 = f32x16{};
#pragma unroll
  for (int d0 = 0; d0 < DQK / 16; ++d0) { int cb = (d0 * 16 + hi * 8) * 2;
    bf16x8 b0 = *reinterpret_cast<const bf16x8*>(Ks + KSWZ(r32, cb));
    bf16x8 b1 = *reinterpret_cast<const bf16x8*>(Ks + KSWZ(32 + r32, cb));
    p0 = __builtin_amdgcn_mfma_f32_32x32x16_bf16(b0, qr[d0], p0, 0, 0, 0);
    p1 = __builtin_amdgcn_mfma_f32_32x32x16_bf16(b1, qr[d0], p1, 0, 0, 0); }
}
__device__ __forceinline__ int v_st(int k, int c) { const int kk = (k & ~0xC) | ((k & 4) << 1) | ((k & 8) >> 1); return ((kk >> 3) * 4 + (c >> 5)) * 512 + ((kk & 7) * 32 + (c & 31)) * 2; }
__device__ __forceinline__ int v_rd_base(int lane) { return ((lane & 3) << 3) | (((lane >> 2) & 3) << 6) | (((lane >> 4) & 1) << 5) | (((lane >> 5) & 1) << 8); }
constexpr int v_rd_off(int d0, int ks, int half) { return d0 * 512 + ks * 4096 + half * 2048; }
template <int OFF> __device__ __forceinline__ s16x4 tr_read(int vb) {
  s16x4 r; asm volatile("ds_read_b64_tr_b16 %0, %1 offset:%2" : "=&v"(r) : "v"(vb), "i"(OFF) : "memory"); return r;
}
#define PKLH(L, H) (bf16x8){L[0], L[1], L[2], L[3], H[0], H[1], H[2], H[3]}
template <int D0> __device__ __forceinline__ void pv_one(f32x16& od, int vb, bf16x8 pa0, bf16x8 pa1, bf16x8 pa2, bf16x8 pa3) {
  const s16x4 l0 = tr_read<v_rd_off(D0, 0, 0)>(vb), h0 = tr_read<v_rd_off(D0, 0, 1)>(vb), l1 = tr_read<v_rd_off(D0, 1, 0)>(vb), h1 = tr_read<v_rd_off(D0, 1, 1)>(vb);
  const s16x4 l2 = tr_read<v_rd_off(D0, 2, 0)>(vb), h2 = tr_read<v_rd_off(D0, 2, 1)>(vb), l3 = tr_read<v_rd_off(D0, 3, 0)>(vb), h3 = tr_read<v_rd_off(D0, 3, 1)>(vb);
  asm volatile("s_waitcnt lgkmcnt(0)" ::: "memory"); SBAR();
  od = __builtin_amdgcn_mfma_f32_32x32x16_bf16(pa0, PKLH(l0, h0), od, 0, 0, 0);
  od = __builtin_amdgcn_mfma_f32_32x32x16_bf16(pa1, PKLH(l1, h1), od, 0, 0, 0);
  od = __builtin_amdgcn_mfma_f32_32x32x16_bf16(pa2, PKLH(l2, h2), od, 0, 0, 0);
  od = __builtin_amdgcn_mfma_f32_32x32x16_bf16(pa3, PKLH(l3, h3), od, 0, 0, 0);
}
__device__ __forceinline__ void pv_d0(f32x16* o, int vb, bf16x8 pa0, bf16x8 pa1, bf16x8 pa2, bf16x8 pa3) {
  pv_one<0>(o[0], vb, pa0, pa1, pa2, pa3); pv_one<1>(o[1], vb, pa0, pa1, pa2, pa3);
}
struct NaInfo { const float* brow; int qr, qc; };
__device__ __forceinline__ void na_bias(f32x16& p0, f32x16& p1, const NaInfo& na, int kr, int hi) {
  const int rs = min(max(na.qr - 4, 0), 120);
  if (kr < rs || kr >= rs + 8) {
#pragma unroll
    for (int r = 0; r < 16; ++r) { p0[r] = -1e30f; p1[r] = -1e30f; }
  } else {
    const float* b = na.brow + (kr - na.qr + 7) * 31 + (15 - na.qc) + 4 * hi;
    const int ws = min(max(na.qc - 8, 0), 48) - 4 * hi;
#pragma unroll
    for (int r = 0; r < 16; ++r) {
      const int kc0 = (r & 3) + 8 * (r >> 2);
      const bool ok1 = (unsigned)(kc0 - ws) < 16u, ok2 = (unsigned)(kc0 + 32 - ws) < 16u;
      const float b1 = b[kc0], b2 = b[kc0 + 32];
      p0[r] = ok1 ? p0[r] + 8.0f * b1 : -1e30f;
      p1[r] = ok2 ? p1[r] + 8.0f * b2 : -1e30f;
      if ((r & 3) == 3) SBAR();
    }
  }
}

template <int DQK, int MODE, int ldq, int ldk, int ldv>
__device__ __forceinline__ void attn_unit(const bf16_t* __restrict__ Qb, const bf16_t* __restrict__ Kp, const bf16_t* __restrict__ Vp,
                                          int rowA, int nA, int rowB, int NT, bf16_t* __restrict__ Ob, char* lds, int rpb_off, int r0, int rs0) {
  constexpr int ldo = DM;
  const int tid = fresh_tid(), wid = tid >> 6, lane = tid & 63, r32 = lane & 31, hi = lane >> 5;
  char* V_lds = lds; char* K_lds = lds + 2 * SHM_V;
  float* ws = (float*)(lds + 2 * SHM_V + 2 * SHM_K) + wid * 64; float* li_l = ws; float* al_l = ws + 32;
  float m_reg = -1e30f, l_reg = 0; f32x16 o[2] = {}; bf16x8 qr[DQK / 16];
  const bf16_t* Qw = Qb + (long)(wid * QBLK + r32) * ldq + hi * 8;
#pragma unroll
  for (int d0 = 0; d0 < DQK / 16; ++d0) qr[d0] = ld8(Qw + d0 * 16);
  NaInfo na; na.brow = (const float*)(lds + rpb_off); na.qr = r0 + (wid >> 1); na.qc = (wid & 1) * 32 + r32;
  const int sr = tid >> 3, sc = (tid & 7) * 8, vst0 = v_st(sr, sc), kst0 = KSWZ(sr, sc * 2);
  const int sr2 = (tid & 255) >> 2, sc2 = 64 + (tid & 3) * 8, kst1 = KSWZ(sr2, sc2 * 2);
  const int vb0 = (int)(uintptr_t)V_lds + v_rd_base(lane);
  struct { bf16x8 vs0, ks0, ks1; } sr_[2];
#define KROW(j) (((j) < nA) ? (rowA + (j) * KVBLK) : (rowB + ((j) - nA) * KVBLK))
#define SLOAD(i, j) do { const long kr_ = KROW(j); sr_[i].vs0 = ld8(Vp + (kr_ + sr) * ldv + sc); sr_[i].ks0 = ld8(Kp + (kr_ + sr) * ldk + sc); \
    if (DQK == 96) sr_[i].ks1 = ld8(Kp + (kr_ + sr2) * ldk + sc2); } while (0)
#define SWRITE(b, i) do { *(bf16x8*)(V_lds + (b) * SHM_V + vst0) = sr_[i].vs0; *(bf16x8*)(K_lds + (b) * SHM_K + kst0) = sr_[i].ks0; \
    if (DQK == 96) *(bf16x8*)(K_lds + (b) * SHM_K + kst1) = sr_[i].ks1; } while (0)
#define RESC(a) do { if (__any((a) < 1.f)) { if (hi == 0) al_l[r32] = (a); asm volatile("s_waitcnt lgkmcnt(0)" ::: "memory"); \
    _Pragma("unroll") for (int d = 0; d < 2; ++d) _Pragma("unroll") for (int r = 0; r < 16; ++r) o[d][r] *= al_l[crow(r, hi)]; } } while (0)
#define BIAS(P0, P1, j) do { if (MODE == 1) { SBAR(); if ((j) >= nA) na_bias(P0, P1, na, rs0 + (j) - nA, hi); SBAR(); } } while (0)
  f32x16 pA0, pA1, pB0, pB1; float mnA, mnB, alA, alB; bf16x8 pa0, pa1, pa2, pa3;
  constexpr int SE = 0, SO = 1;
  SLOAD(SE, 0); SLOAD(SO, 1); asm volatile("s_waitcnt vmcnt(0)" ::: "memory"); SWRITE(0, SE); SWRITE(1, SO);
  if (2 < NT) SLOAD(SE, 2);
  __syncthreads();
  qkt<DQK>(pA0, pA1, K_lds, qr, r32, hi); BIAS(pA0, pA1, 0); partialSM<DQK>(pA0, pA1, m_reg, mnA, alA);
  for (int j = 1; j + 1 < NT; j += 2) {
    SBAR(); qkt<DQK>(pB0, pB1, K_lds + SHM_K, qr, r32, hi);
    finishSM(pA0, pA1, alA, l_reg, pa0, pa1, pa2, pa3); SBAR();
    SLOAD(SO, j + 2); SBAR();
    pv_d0(o, vb0, pa0, pa1, pa2, pa3); BIAS(pB0, pB1, j); partialSM<DQK>(pB0, pB1, m_reg, mnB, alB);
    __syncthreads(); SWRITE(0, SE);
    RESC(alB); __syncthreads();
    SBAR(); qkt<DQK>(pA0, pA1, K_lds, qr, r32, hi);
    finishSM(pB0, pB1, alB, l_reg, pa0, pa1, pa2, pa3); SBAR();
    if (j + 3 < NT) SLOAD(SE, j + 3); SBAR();
    pv_d0(o, vb0 + (int)SHM_V, pa0, pa1, pa2, pa3); BIAS(pA0, pA1, j + 1); partialSM<DQK>(pA0, pA1, m_reg, mnA, alA);
    __syncthreads(); SWRITE(1, SO);
    RESC(alA); __syncthreads();
  }
  SBAR(); qkt<DQK>(pB0, pB1, K_lds + SHM_K, qr, r32, hi);
  finishSM(pA0, pA1, alA, l_reg, pa0, pa1, pa2, pa3); SBAR();
  pv_d0(o, vb0, pa0, pa1, pa2, pa3); BIAS(pB0, pB1, NT - 1); partialSM<DQK>(pB0, pB1, m_reg, mnB, alB);
  __syncthreads(); RESC(alB);
  finishSM(pB0, pB1, alB, l_reg, pa0, pa1, pa2, pa3); SBAR();
  pv_d0(o, vb0 + (int)SHM_V, pa0, pa1, pa2, pa3);
  if (hi == 0) li_l[r32] = l_reg; asm volatile("s_waitcnt lgkmcnt(0)" ::: "memory");
  float rli[16];
#pragma unroll
  for (int r = 0; r < 16; ++r) rli[r] = __builtin_amdgcn_rcpf(li_l[crow(r, hi)]);
  bf16_t* Ow = Ob + (long)(wid * QBLK) * ldo;
#pragma unroll
  for (int r = 0; r < 16; ++r) { const int orow = crow(r, hi);
#pragma unroll
    for (int d0 = 0; d0 < 2; ++d0) { const unsigned w = cvtpk(o[d0][r] * rli[r], 0.f); Ow[(long)orow * ldo + d0 * 32 + r32] = (bf16_t)(w & 0xffffu); } }
  __syncthreads();
#undef KROW
#undef SLOAD
#undef SWRITE
#undef RESC
#undef BIAS
}
}

constexpr int NWAVES = 8, NTHR = 512;
constexpr int RING_BYTES = 131072;
constexpr int MISC_OFF = RING_BYTES;
constexpr int LDS_BYTES = 147456;
typedef unsigned short bf16;
typedef unsigned v4u __attribute__((ext_vector_type(4)));
typedef unsigned v2u __attribute__((ext_vector_type(2)));
typedef float f32x4 __attribute__((ext_vector_type(4)));

__device__ __forceinline__ unsigned f2bf(float f) { unsigned u = __builtin_bit_cast(unsigned, f); return (u + 0x7fffu + ((u >> 16) & 1u)) >> 16; }
__device__ __forceinline__ unsigned pk2(float lo, float hi) { return f2bf(lo) | (f2bf(hi) << 16); }
__device__ __forceinline__ float bf2f(unsigned short b) { return __builtin_bit_cast(float, (unsigned)b << 16); }
__device__ __forceinline__ float wave_sum(float v) {
#pragma unroll
    for (int o = 1; o < 64; o <<= 1) v += __shfl_xor(v, o);
    return v;
}
__device__ __forceinline__ float siluf(float x) { return x / (1.0f + __expf(-x)); }

struct Args { const float* in[22]; float* out; unsigned char* ws; int ph_lo, ph_hi; };

struct Ctx {
    char* lds; int tid, lane, wave, vcu, G, bx; unsigned argoff;
    unsigned char* ws;
};

constexpr int ARGS_OFF = MISC_OFF + 12288;
__device__ __forceinline__ const float* inptr(const Ctx& F, int i) {
    const __attribute__((address_space(3))) unsigned* p = (const __attribute__((address_space(3))) unsigned*)(uintptr_t)(F.argoff + 8u * (unsigned)i);
    const unsigned lo = __builtin_amdgcn_readfirstlane(p[0]), hi = __builtin_amdgcn_readfirstlane(p[1]);
    return (const float*)(const __attribute__((address_space(1))) float*)(((unsigned long long)hi << 32) | lo);
}
__device__ __forceinline__ void refresh(Ctx& F) { F.tid = fresh_tid(); F.lane = F.tid & 63; F.wave = __builtin_amdgcn_readfirstlane(F.tid >> 6); }
__device__ __forceinline__ void tr_item(const float* W, int ldw, int ncols, bf16* WT, int ldt, int row_off, float* scr, int item, int lane, const float* kscale) {
    const int nblk = ncols / 32, kb = item / nblk, nb = item % nblk, k0 = 64 * kb, n0 = 32 * nb;
#pragma unroll 8
    for (int i = 0; i < 32; ++i) { const int kk = 2 * i + (lane >> 5); float v = W[(size_t)(k0 + kk) * ldw + n0 + (lane & 31)]; if (kscale) v *= kscale[k0 + kk]; scr[kk * 33 + (lane & 31)] = v; }
    asm volatile("s_waitcnt lgkmcnt(0)" ::: "memory");
    const int c = lane & 7;
#pragma unroll
    for (int j = 0; j < 4; ++j) { const int n = (lane >> 3) + 8 * j; const float* s = scr + (8 * c) * 33 + n;
        v4u o; o.x = pk2(s[0 * 33], s[1 * 33]); o.y = pk2(s[2 * 33], s[3 * 33]); o.z = pk2(s[4 * 33], s[5 * 33]); o.w = pk2(s[6 * 33], s[7 * 33]);
        *(v4u*)(WT + (size_t)(row_off + n0 + n) * ldt + k0 + 8 * c) = o; }
    asm volatile("s_waitcnt lgkmcnt(0)" ::: "memory");
}
__device__ __forceinline__ void fz_item(const float* Win, bf16* WinT, const float* tab64, int item, int lane) {
    const int part = item & 1, mb = (item >> 1) & 7, g = (item >> 4) & 3, kb = item >> 6, k0 = 64 * kb;
    f32x4 wr[16];
    const float* rowp = Win + (size_t)(k0 + lane) * D_IN + 1184 + 64 * g;
#pragma unroll
    for (int i = 0; i < 16; ++i) wr[i] = *(const f32x4*)(rowp + 4 * i);
    const int sh = part ? 48 : 0;
    for (int mm = 0; mm < 8; ++mm) {
        const int m = mb * 8 + mm; float acc = 0.f;
#pragma unroll
        for (int c = 0; c < 64; ++c) { const int t = (m * c + sh) & 63; acc += wr[c >> 2][c & 3] * tab64[t]; }
        WinT[(size_t)((part ? PC_ZI : PC_ZR) + 64 * g + m) * DM + k0 + lane] = (bf16)f2bf(acc);
    }
}

__device__ __forceinline__ void phase_prologue(Ctx& F) {
    refresh(F);
    unsigned char* ws = F.ws;
    float* mod = (float*)(ws + WS_MOD);
    const int tid = F.tid, lane = F.lane, wave = F.wave;
    float* tab64 = (float*)(F.lds + MISC_OFF);
    if (tid < 64) tab64[tid] = __builtin_amdgcn_cosf((float)tid * (1.0f / 64.0f));
    if (F.bx < 192) {
        float* sl = (float*)F.lds; float* red = (float*)(F.lds + 32768);
        for (int i = tid; i < 5 * DM; i += NTHR) { const int s = i >> 10, k = i & 1023; sl[i] = siluf(s < 4 ? inptr(F, 1)[s * DM + k] : inptr(F, 3)[k]); }
        __syncthreads();
        for (int item = F.bx; item < 192; item += F.G) {
            const int l = item / 96, j0 = (item % 96) * 64, cl = tid & 63, ks = tid >> 6;
            const float* wm = inptr(F, 4) + ((size_t)l * DM + ks * 128) * MODW + j0 + cl;
            float a0 = 0, a1 = 0, a2 = 0, a3 = 0, a4 = 0;
            for (int k8 = 0; k8 < 128; k8 += 16) { float w[16];
#pragma unroll
                for (int q = 0; q < 16; ++q) w[q] = wm[(size_t)(k8 + q) * MODW];
#pragma unroll
                for (int q = 0; q < 16; ++q) { const int kk = ks * 128 + k8 + q;
                    a0 += sl[kk] * w[q]; a1 += sl[1024 + kk] * w[q]; a2 += sl[2048 + kk] * w[q]; a3 += sl[3072 + kk] * w[q]; a4 += sl[4096 + kk] * w[q]; } }
            red[(ks * 5 + 0) * 64 + cl] = a0; red[(ks * 5 + 1) * 64 + cl] = a1; red[(ks * 5 + 2) * 64 + cl] = a2; red[(ks * 5 + 3) * 64 + cl] = a3; red[(ks * 5 + 4) * 64 + cl] = a4;
            __syncthreads();
            if (tid < 320) { const int s = tid >> 6; float v = inptr(F, 5)[l * MODW + j0 + cl];
                for (int q = 0; q < 8; ++q) v += red[(q * 5 + s) * 64 + cl];
                mod[(size_t)(l * 5 + s) * MODW + j0 + cl] = v; }
            __syncthreads();
        }
    }
    __syncthreads();
    if (F.bx == F.G - 1) {
        float* rope = (float*)(ws + WS_ROPE);
        for (int i = tid; i < 1024; i += NTHR) { const int pos = i >> 3, f = i & 7; const float inv = exp2f(-(float)f * (13.287712379549449f / 8.0f));
            const float rev = (float)pos * inv * 0.15915494309189535f; rope[2 * i] = __builtin_amdgcn_cosf(rev); rope[2 * i + 1] = __builtin_amdgcn_sinf(rev); }
    }
    if (F.bx == 0) { unsigned* bw = (unsigned*)(ws + WS_BAR); for (int i = tid; i < 3456; i += NTHR) bw[i] = 0u; }
    const int gt = F.bx * NTHR + tid, GT = F.G * NTHR;
    { float* z = (float*)(ws + WS_STAT); for (int i = gt; i < 8 * MT; i += GT) z[i] = 0.f; }
    for (int l = 0; l < 2; ++l) {
        v4u zz = {0u, 0u, 0u, 0u};
        bf16* wi = (bf16*)(ws + WS_WIN) + (size_t)l * NP * DM + (size_t)2208 * DM;
        for (int i = gt; i < 96 * DM / 8; i += GT) *(v4u*)(wi + (size_t)i * 8) = zz;
        bf16* wq = (bf16*)(ws + WS_WUQ) + (size_t)l * 512 * 256 + (size_t)384 * 256;
        for (int i = gt; i < 128 * 256 / 8; i += GT) *(v4u*)(wq + (size_t)i * 8) = zz;
        bf16* wk = (bf16*)(ws + WS_WUKV) + (size_t)l * 512 * 256;
        for (int i = gt; i < 512 * 16; i += GT) *(v4u*)(wk + (size_t)(i >> 4) * 256 + 128 + (i & 15) * 8) = zz;
    }
    float* scr = (float*)(F.lds + wave * 16384);
    const int gw = F.vcu * NWAVES + wave, NGW = F.G * NWAVES;
    constexpr int I_A = 16 * 37, I_B = 16 * 16, I_Q = 4 * 12, I_KV = 2 * 16, I_O = 16 * 32, I_1 = 16 * 128, I_2 = 64 * 32, I_FZ = 1024;
    constexpr int I_L = I_A + I_B + I_Q + I_KV + I_O + I_1 + I_2 + I_FZ;
    for (int it = gw; it < 2 * I_L; it += NGW) {
        const int l = it / I_L; int r = it % I_L;
        const float* win = inptr(F, 8) + (size_t)l * DM * D_IN; bf16* winT = (bf16*)(ws + WS_WIN) + (size_t)l * NP * DM;
        if (r < I_A) { tr_item(win, D_IN, 1184, winT, DM, 0, scr, r, lane, nullptr); continue; } r -= I_A;
        if (r < I_B) { tr_item(win + 1440, D_IN, 512, winT, DM, PC_CV, scr, r, lane, nullptr); continue; } r -= I_B;
        if (r < I_Q) { tr_item(inptr(F, 10) + (size_t)l * 256 * 384, 384, 384, (bf16*)(ws + WS_WUQ) + (size_t)l * 512 * 256, 256, 0, scr, r, lane, inptr(F, 9) + l * 256); continue; } r -= I_Q;
        if (r < I_KV) { tr_item(inptr(F, 12) + (size_t)l * 128 * 512, 512, 512, (bf16*)(ws + WS_WUKV) + (size_t)l * 512 * 256, 256, 0, scr, r, lane, inptr(F, 11) + l * 128); continue; } r -= I_KV;
        if (r < I_O) { tr_item(inptr(F, 18) + (size_t)l * DM * DM, DM, DM, (bf16*)(ws + WS_WOUT) + (size_t)l * DM * DM, DM, 0, scr, r, lane, nullptr); continue; } r -= I_O;
        if (r < I_1) { tr_item(inptr(F, 19) + (size_t)l * DM * DFF, DFF, DFF, (bf16*)(ws + WS_W1) + (size_t)l * DM * DFF, DM, 0, scr, r, lane, nullptr); continue; } r -= I_1;
        if (r < I_2) { tr_item(inptr(F, 20) + (size_t)l * DFF * DM, DM, DM, (bf16*)(ws + WS_W2) + (size_t)l * DM * DFF, DFF, 0, scr, r, lane, nullptr); continue; } r -= I_2;
        fz_item(win, winT, tab64, r, lane);
    }
}

__device__ __forceinline__ void phase_xs(Ctx& F, const float* xlat, const float* xctx, const float* g, const float* modl, float* ss1, bf16* XS) {
    refresh(F);
    const int gw = F.vcu * NWAVES + F.wave, NGW = F.G * NWAVES, lane = F.lane;
    for (int row0 = 2 * gw; row0 < MT; row0 += 2 * NGW) {
        f32x4 v[2][4]; float ss[2] = {0.f, 0.f};
#pragma unroll
        for (int q = 0; q < 2; ++q) { const int row = row0 + q;
            const float* xr = row < ML ? xlat + (size_t)row * DM : xctx + (size_t)(row - ML) * DM;
#pragma unroll
            for (int j = 0; j < 4; ++j) v[q][j] = __builtin_nontemporal_load((const f32x4*)(xr + 256 * j + 4 * lane)); }
#pragma unroll
        for (int q = 0; q < 2; ++q) { const int row = row0 + q; const int s = row < ML ? (row >> 13) : 4;
            const float* sc = modl + s * MODW + DM;
#pragma unroll
            for (int j = 0; j < 4; ++j) ss[q] += (v[q][j][0] * v[q][j][0] + v[q][j][1] * v[q][j][1]) + (v[q][j][2] * v[q][j][2] + v[q][j][3] * v[q][j][3]);
            ss[q] = wave_sum(ss[q]);
            if (lane == 0) ss1[row] = ss[q];
#pragma unroll
            for (int j = 0; j < 4; ++j) { const int c = 256 * j + 4 * lane;
                const f32x4 gg = *(const f32x4*)(g + c), s1 = *(const f32x4*)(sc + c);
                const f32x4 y = v[q][j] * gg * (s1 + 1.0f);
                v2u w; w.x = pk2(y[0], y[1]); w.y = pk2(y[2], y[3]); *(v2u*)(XS + (size_t)row * DM + c) = w; } }
    }
}
constexpr int KSPLIT = 8;
__device__ __forceinline__ void phase_xs_ctx(Ctx& F, float* xctx, const float* part, const float* gate4, const float* g, const float* modl, float* ss1, bf16* XS) {
    refresh(F);
    const int gw = F.vcu * NWAVES + F.wave, NGW = F.G * NWAVES, lane = F.lane;
    for (int r = gw; r < MC; r += NGW) {
        const int row = ML + r;
        float* xr = xctx + (size_t)r * DM; const float* sc = modl + 4 * MODW + DM;
        f32x4 v[4]; float ss = 0.f;
#pragma unroll
        for (int j = 0; j < 4; ++j) { const int c = 256 * j + 4 * lane; f32x4 a = {0.f, 0.f, 0.f, 0.f};
#pragma unroll
            for (int ks = 0; ks < KSPLIT; ++ks) a += *(const f32x4*)(part + ((size_t)ks * MC + r) * DM + c);
            v[j] = *(const f32x4*)(xr + c) + *(const f32x4*)(gate4 + c) * a; *(f32x4*)(xr + c) = v[j];
            ss += (v[j][0] * v[j][0] + v[j][1] * v[j][1]) + (v[j][2] * v[j][2] + v[j][3] * v[j][3]); }
        ss = wave_sum(ss);
        if (lane == 0) ss1[row] = ss;
#pragma unroll
        for (int j = 0; j < 4; ++j) { const int c = 256 * j + 4 * lane;
            const f32x4 gg = *(const f32x4*)(g + c), s1 = *(const f32x4*)(sc + c);
            const f32x4 y = v[j] * gg * (s1 + 1.0f);
            v2u w; w.x = pk2(y[0], y[1]); w.y = pk2(y[2], y[3]); *(v2u*)(XS + (size_t)row * DM + c) = w; }
    }
}
__device__ __forceinline__ void phase_bias(Ctx& F) {
    refresh(F);
    unsigned char* ws = F.ws;
    const int gw = F.vcu * NWAVES + F.wave, NGW = F.G * NWAVES, lane = F.lane;
    for (int grp = 0; grp < 4; ++grp) {
        const int l = grp >> 1, which = grp & 1, nrows = which ? DFF : NP;
        const float* shb = (const float*)(ws + WS_MOD) + (size_t)l * 5 * MODW + (which ? 3 * DM : 0) + 16 * lane;
        const bf16* W = which ? (const bf16*)(ws + WS_W1) + (size_t)l * DM * DFF : (const bf16*)(ws + WS_WIN) + (size_t)l * NP * DM;
        float* outp = which ? (float*)(ws + WS_B2) + (size_t)l * 5 * DFF : (float*)(ws + WS_B1) + (size_t)l * 5 * NP;
        for (int n0 = gw; n0 < nrows; n0 += 2 * NGW) {
            const int n1 = n0 + NGW; const bool h1 = n1 < nrows; const int n1c = h1 ? n1 : n0;
            const v4u wa0 = *(const v4u*)(W + (size_t)n0 * DM + 16 * lane), wa1 = *(const v4u*)(W + (size_t)n0 * DM + 16 * lane + 8);
            const v4u wb0 = *(const v4u*)(W + (size_t)n1c * DM + 16 * lane), wb1 = *(const v4u*)(W + (size_t)n1c * DM + 16 * lane + 8);
            float fa[16], fb[16];
#pragma unroll
            for (int q = 0; q < 4; ++q) { fa[2 * q] = __builtin_bit_cast(float, wa0[q] << 16); fa[2 * q + 1] = __builtin_bit_cast(float, wa0[q] & 0xffff0000u);
                fa[8 + 2 * q] = __builtin_bit_cast(float, wa1[q] << 16); fa[8 + 2 * q + 1] = __builtin_bit_cast(float, wa1[q] & 0xffff0000u);
                fb[2 * q] = __builtin_bit_cast(float, wb0[q] << 16); fb[2 * q + 1] = __builtin_bit_cast(float, wb0[q] & 0xffff0000u);
                fb[8 + 2 * q] = __builtin_bit_cast(float, wb1[q] << 16); fb[8 + 2 * q + 1] = __builtin_bit_cast(float, wb1[q] & 0xffff0000u); }
#pragma unroll
            for (int sI = 0; sI < 5; ++sI) { float a = 0.f, b = 0.f;
#pragma unroll
                for (int q = 0; q < 4; ++q) { const f32x4 hv = *(const f32x4*)(shb + sI * MODW + 4 * q);
                    a += (hv[0] * fa[4 * q] + hv[1] * fa[4 * q + 1]) + (hv[2] * fa[4 * q + 2] + hv[3] * fa[4 * q + 3]);
                    b += (hv[0] * fb[4 * q] + hv[1] * fb[4 * q + 1]) + (hv[2] * fb[4 * q + 2] + hv[3] * fb[4 * q + 3]); }
                a = wave_sum(a); b = wave_sum(b);
                if (lane == 0) { outp[sI * nrows + n0] = a; if (h1) outp[sI * nrows + n1] = b; } }
        }
    }
}
__device__ __forceinline__ void phase_final(Ctx& F, const bf16* xr, float* out, const float* g) {
    refresh(F);
    const int gw = F.vcu * NWAVES + F.wave, NGW = F.G * NWAVES, lane = F.lane;
    f32x4 gg[4];
#pragma unroll
    for (int j = 0; j < 4; ++j) gg[j] = *(const f32x4*)(g + 256 * j + 4 * lane);
    for (int row0 = 4 * gw; row0 < ML; row0 += 4 * NGW) {
        v2u w[4][4];
#pragma unroll
        for (int q = 0; q < 4; ++q)
#pragma unroll
            for (int j = 0; j < 4; ++j) w[q][j] = *(const v2u*)(xr + (size_t)(row0 + q) * DM + 256 * j + 4 * lane);
#pragma unroll
        for (int q = 0; q < 4; ++q) { f32x4 v[4]; float ss = 0.f;
#pragma unroll
            for (int j = 0; j < 4; ++j) { v[j] = (f32x4){__builtin_bit_cast(float, w[q][j].x << 16), __builtin_bit_cast(float, w[q][j].x & 0xffff0000u), __builtin_bit_cast(float, w[q][j].y << 16), __builtin_bit_cast(float, w[q][j].y & 0xffff0000u)};
                ss += (v[j][0] * v[j][0] + v[j][1] * v[j][1]) + (v[j][2] * v[j][2] + v[j][3] * v[j][3]); }
            const float r = 1.0f / sqrtf(wave_sum(ss) * (1.0f / DM) + EPS);
#pragma unroll
            for (int j = 0; j < 4; ++j) __builtin_nontemporal_store(v[j] * r * gg[j], (f32x4*)(out + (size_t)(row0 + q) * DM + 256 * j + 4 * lane)); }
    }
}

__device__ __forceinline__ void conv_unit(Ctx& F, const bf16* P, bf16* O, int seq_row0, int seq_len, int t0, const float* wdw, const float* bdw, const float* lng, const float* lnb) {
    refresh(F);
    float* y = (float*)F.lds;
    const int tid = F.tid;
    {
        v4u av[6], gv[6]; bool okv[6];
#pragma unroll
        for (int q = 0; q < 6; ++q) { const int i = tid + q * NTHR, r = i >> 5, c8 = (i & 31) * 8, t = t0 - 15 + r;
            okv[q] = (i < 94 * 32) && t >= 0 && t < seq_len;
            const bf16* pr = P + (size_t)(seq_row0 + (okv[q] ? t : 0)) * NP + PC_CV + c8;
            av[q] = okv[q] ? *(const v4u*)pr : (v4u){0u, 0u, 0u, 0u}; gv[q] = okv[q] ? *(const v4u*)(pr + 256) : (v4u){0u, 0u, 0u, 0u}; }
#pragma unroll
        for (int q = 0; q < 6; ++q) { const int i = tid + q * NTHR, r = i >> 5, c8 = (i & 31) * 8;
            float o[8];
#pragma unroll
            for (int w = 0; w < 4; ++w) { const unsigned aw = av[q][w], gw = gv[q][w];
                const float a0 = __builtin_bit_cast(float, aw << 16), a1 = __builtin_bit_cast(float, aw & 0xffff0000u), g0 = __builtin_bit_cast(float, gw << 16), g1 = __builtin_bit_cast(float, gw & 0xffff0000u);
                o[2 * w] = okv[q] ? a0 / (1.0f + __expf(-g0)) : 0.f; o[2 * w + 1] = okv[q] ? a1 / (1.0f + __expf(-g1)) : 0.f; }
            if (i < 94 * 32) { *(f32x4*)(y + r * 256 + c8) = (f32x4){o[0], o[1], o[2], o[3]}; *(f32x4*)(y + r * 256 + c8 + 4) = (f32x4){o[4], o[5], o[6], o[7]}; } }
    }
    __syncthreads();
    const int c = tid & 255, hf = tid >> 8;
    float w[31];
#pragma unroll
    for (int k = 0; k < 31; ++k) w[k] = wdw[k * 256 + c];
    const float bb = bdw[c];
    float outv[32];
#pragma unroll
    for (int tt = 0; tt < 32; ++tt) { float a = bb; const float* yp = y + (hf * 32 + tt) * 256 + c;
#pragma unroll
        for (int k = 0; k < 31; ++k) a += w[k] * yp[k * 256];
        outv[tt] = a; }
    __syncthreads();
#pragma unroll
    for (int tt = 0; tt < 32; ++tt) y[(hf * 32 + tt) * 256 + c] = outv[tt];
    __syncthreads();
    const int lane = F.lane, wave = F.wave;
    const f32x4 gg = *(const f32x4*)(lng + 4 * lane), be = *(const f32x4*)(lnb + 4 * lane);
    for (int q = 0; q < 8; ++q) {
        const int tt = wave * 8 + q;
        const f32x4 v = *(const f32x4*)(y + tt * 256 + 4 * lane);
        const float mu = wave_sum((v[0] + v[1]) + (v[2] + v[3])) * (1.0f / 256.0f);
        const f32x4 d = v - mu;
        const float var = wave_sum((d[0] * d[0] + d[1] * d[1]) + (d[2] * d[2] + d[3] * d[3])) * (1.0f / 256.0f);
        const float rs = 1.0f / sqrtf(var + EPS);
        f32x4 o = d * rs * gg + be;
#pragma unroll
        for (int j = 0; j < 4; ++j) o[j] = siluf(o[j]);
        v2u wv; wv.x = pk2(o[0], o[1]); wv.y = pk2(o[2], o[3]);
        *(v2u*)(O + (size_t)(seq_row0 + t0 + tt) * DM + 768 + 4 * lane) = wv;
    }
    __syncthreads();
}

__device__ __forceinline__ void fourier_step1(Ctx& F, const bf16* P, bf16* Y) {
    refresh(F);
    using namespace att;
    const int tid = F.tid, lane = F.lane, wave = F.wave, r32 = lane & 31, hi = lane >> 5;
    bf16x8 afr[16];
    { const int k1 = 16 * wave + (r32 & 15); const bool isV = r32 >= 16;
#pragma unroll
      for (int s = 0; s < 16; ++s) {
        unsigned wv[4];
#pragma unroll
        for (int i2 = 0; i2 < 4; ++i2) { float e[2];
#pragma unroll
            for (int q = 0; q < 2; ++q) { const int kk = 16 * s + 8 * hi + 2 * i2 + q, part = kk >> 7, n1 = kk & 127; const int t = (k1 * n1) & 127;
                const float cs = __builtin_amdgcn_cosf((float)t * (1.0f / 128.0f)), sn = __builtin_amdgcn_sinf((float)t * (1.0f / 128.0f));
                e[q] = isV ? (part ? cs : sn) : (part ? -sn : cs); }
            wv[i2] = pk2(e[0], e[1]); }
        u32x4 w = {wv[0], wv[1], wv[2], wv[3]}; afr[s] = *reinterpret_cast<bf16x8*>(&w);
      } }
    char* img = F.lds;
    const int vb = (int)(uintptr_t)img + v_rd_base(lane);
    for (int prob = F.vcu; prob < 256; prob += F.G) {
        const int b = prob >> 6, n2 = prob & 63;
        for (int ch = 0; ch < 2; ++ch) {
#pragma unroll
            for (int q = 0; q < 8; ++q) { const int idx = q * NTHR + tid, kb = idx >> 10, k = (idx >> 4) & 63, c = (idx & 15) * 8;
                const int part = kb >> 1, n1 = (kb & 1) * 64 + k;
                const bf16x8 v = ld8(P + (size_t)(b * SEQ + 64 * n1 + n2) * NP + (part ? PC_ZI : PC_ZR) + 128 * ch + c);
                *(bf16x8*)(img + kb * 16384 + v_st(k, c)) = v; }
            __syncthreads();
#define F1_Q(Q, D0) do { \
                const s16x4 l0 = tr_read<(Q) * 16384 + v_rd_off(D0, 0, 0)>(vb), h0 = tr_read<(Q) * 16384 + v_rd_off(D0, 0, 1)>(vb), l1 = tr_read<(Q) * 16384 + v_rd_off(D0, 1, 0)>(vb), h1 = tr_read<(Q) * 16384 + v_rd_off(D0, 1, 1)>(vb); \
                const s16x4 l2 = tr_read<(Q) * 16384 + v_rd_off(D0, 2, 0)>(vb), h2 = tr_read<(Q) * 16384 + v_rd_off(D0, 2, 1)>(vb), l3 = tr_read<(Q) * 16384 + v_rd_off(D0, 3, 0)>(vb), h3 = tr_read<(Q) * 16384 + v_rd_off(D0, 3, 1)>(vb); \
                asm volatile("s_waitcnt lgkmcnt(0)" ::: "memory"); SBAR(); \
                acc = __builtin_amdgcn_mfma_f32_32x32x16_bf16(afr[4 * (Q) + 0], PKLH(l0, h0), acc, 0, 0, 0); acc = __builtin_amdgcn_mfma_f32_32x32x16_bf16(afr[4 * (Q) + 1], PKLH(l1, h1), acc, 0, 0, 0); \
                acc = __builtin_amdgcn_mfma_f32_32x32x16_bf16(afr[4 * (Q) + 2], PKLH(l2, h2), acc, 0, 0, 0); acc = __builtin_amdgcn_mfma_f32_32x32x16_bf16(afr[4 * (Q) + 3], PKLH(l3, h3), acc, 0, 0, 0); } while (0)
#define F1_D0(D0) do { f32x16 acc = {}; \
            F1_Q(0, D0); F1_Q(1, D0); F1_Q(2, D0); F1_Q(3, D0); \
            const int col = 128 * ch + 32 * (D0) + r32; \
            _Pragma("unroll") for (int r = 0; r < 8; ++r) { const int k1 = 16 * wave + crow(r, hi); const float rev = (float)(k1 * n2) * (1.0f / 8192.0f); \
                const float cb = __builtin_amdgcn_cosf(rev), sb = __builtin_amdgcn_sinf(rev); const float U = acc[r], V = acc[r + 8]; \
                bf16* yp = Y + ((size_t)((b * 128 + k1) * 2) * 64 + n2) * 256 + col; \
                yp[0] = (bf16)f2bf(U * cb - V * sb); yp[(size_t)64 * 256] = (bf16)f2bf(U * sb + V * cb); } } while (0)
            F1_D0(0); F1_D0(1); F1_D0(2); F1_D0(3);
#undef F1_D0
#undef F1_Q
            __syncthreads();
        }
    }
}
__device__ __forceinline__ void fourier_step2(Ctx& F, const bf16* Y, bf16* O) {
    refresh(F);
    using namespace att;
    const int tid = F.tid, lane = F.lane, wave = F.wave, r32 = lane & 31, hi = lane >> 5;
    bf16x8 afr[2][8];
#pragma unroll
    for (int mt = 0; mt < 2; ++mt)
#pragma unroll
      for (int s = 0; s < 8; ++s) { const int k2 = 32 * mt + r32;
        unsigned wv[4];
#pragma unroll
        for (int i2 = 0; i2 < 4; ++i2) { float e[2];
#pragma unroll
            for (int q = 0; q < 2; ++q) { const int kk = 16 * s + 8 * hi + 2 * i2 + q, part = kk >> 6, n2 = kk & 63; const int t = (k2 * n2) & 63;
                e[q] = part ? -__builtin_amdgcn_sinf((float)t * (1.0f / 64.0f)) : __builtin_amdgcn_cosf((float)t * (1.0f / 64.0f)); }
            wv[i2] = pk2(e[0], e[1]); }
        u32x4 w = {wv[0], wv[1], wv[2], wv[3]}; afr[mt][s] = *reinterpret_cast<bf16x8*>(&w); }
    char* img = F.lds;
    const int ch = wave >> 2, d0 = wave & 3;
    const int vb = (int)(uintptr_t)img + v_rd_base(lane) + ch * 32768 + d0 * 512;
    const float scale = 0.0013810679320049757f;
    for (int prob = F.vcu; prob < 512; prob += F.G) {
        const int b = prob >> 7, k1 = prob & 127;
        const bf16* src = Y + (size_t)((b * 128 + k1) * 2) * 64 * 256;
#pragma unroll
        for (int q = 0; q < 8; ++q) { const int idx = q * NTHR + tid, key = idx >> 5, c = (idx & 31) * 8;
            const bf16x8 v = ld8(src + (size_t)key * 256 + c);
            *(bf16x8*)(img + (c >> 7) * 32768 + (key >> 6) * 16384 + v_st(key & 63, c & 127)) = v; }
        __syncthreads();
        f32x16 acc0 = {}, acc1 = {};
#define F2_S(S, KB, KS) do { const s16x4 lo = tr_read<(KB) * 16384 + v_rd_off(0, KS, 0)>(vb), hh = tr_read<(KB) * 16384 + v_rd_off(0, KS, 1)>(vb); \
            asm volatile("s_waitcnt lgkmcnt(0)" ::: "memory"); SBAR(); const bf16x8 bb = PKLH(lo, hh); \
            acc0 = __builtin_amdgcn_mfma_f32_32x32x16_bf16(afr[0][S], bb, acc0, 0, 0, 0); acc1 = __builtin_amdgcn_mfma_f32_32x32x16_bf16(afr[1][S], bb, acc1, 0, 0, 0); } while (0)
        F2_S(0, 0, 0); F2_S(1, 0, 1); F2_S(2, 0, 2); F2_S(3, 0, 3); F2_S(4, 1, 0); F2_S(5, 1, 1); F2_S(6, 1, 2); F2_S(7, 1, 3);
#undef F2_S
        const int col = 512 + 32 * wave + r32;
#pragma unroll
        for (int r = 0; r < 16; ++r) { const int k2 = crow(r, hi);
            O[(size_t)(b * SEQ + k1 + 128 * k2) * DM + col] = (bf16)f2bf(acc0[r] * scale);
            O[(size_t)(b * SEQ + k1 + 128 * (k2 + 32)) * DM + col] = (bf16)f2bf(acc1[r] * scale); }
        __syncthreads();
    }
}
__device__ __forceinline__ void fourier_ctx(Ctx& F, const bf16* P, bf16* O) {
    refresh(F);
    float* tab = (float*)(F.lds + MISC_OFF + 512);
    const int tid = F.tid;
    if (tid < 256) tab[tid] = __builtin_amdgcn_cosf((float)tid * (1.0f / 256.0f));
    __syncthreads();
    const int col = tid & 255, kh = tid >> 8;
    for (int item = F.vcu; item < 256; item += F.G) {
        const int b = item >> 6, kq = (item & 63) * 4 + kh * 2;
        float a0 = 0.f, a1 = 0.f;
        const bf16* src = P + (size_t)(ML + b * CTXL) * NP;
        for (int n8 = 0; n8 < 256; n8 += 8) {
            unsigned short zr_[8], zi_[8];
#pragma unroll
            for (int q = 0; q < 8; ++q) { zr_[q] = src[(size_t)(n8 + q) * NP + PC_ZR + col]; zi_[q] = src[(size_t)(n8 + q) * NP + PC_ZI + col]; }
#pragma unroll
            for (int q = 0; q < 8; ++q) { const int n = n8 + q; const float zr = bf2f(zr_[q]), zi = bf2f(zi_[q]);
                const int i0 = (kq * n) & 255, i1 = ((kq + 1) * n) & 255;
                a0 += zr * tab[i0] - zi * tab[(i0 + 192) & 255];
                a1 += zr * tab[i1] - zi * tab[(i1 + 192) & 255]; }
        }
        O[(size_t)(ML + b * CTXL + kq) * DM + 512 + col] = (bf16)f2bf(a0 * (1.0f / 128.0f));
        O[(size_t)(ML + b * CTXL + kq + 1) * DM + 512 + col] = (bf16)f2bf(a1 * (1.0f / 128.0f));
    }
}

#define LAS __attribute__((address_space(3)))
#define XB_TMO      128
#define XB_XCNT(j)  (256  + 64 * (j))
#define XB_XSUB(j)  (1280 + 64 * (j))
#define XB_XGEN(j)  (2304 + 64 * (j))
#define XB_TOP      3328
#define XB_TOPGEN   3392
#define XCD_BAR_WORDS 3456
#define XB_SPIN_CAP (1u << 18)

__device__ __forceinline__ unsigned xb_ld(unsigned* p)              { return __hip_atomic_load(p, __ATOMIC_RELAXED, __HIP_MEMORY_SCOPE_AGENT); }
__device__ __forceinline__ unsigned xb_add(unsigned* p, unsigned v) { return __hip_atomic_fetch_add(p, v, __ATOMIC_RELAXED, __HIP_MEMORY_SCOPE_AGENT); }
__device__ __forceinline__ unsigned xb_xcc_id() { return (unsigned)__builtin_amdgcn_s_getreg((3 << 11) | 20) & 0xFu; }
#define XB_SPIN(cond, bar) do { unsigned _sp = 0; while (cond) { __builtin_amdgcn_s_sleep(1); \
    if ((++_sp & 255u) == 0u) { if (xb_ld(&(bar)[XB_TMO])) break; if (_sp > XB_SPIN_CAP) { atomicAdd(&(bar)[XB_TMO], 1u); break; } } } } while (0)

struct XcdBarrier {
    unsigned* bar; unsigned x;
    volatile LAS unsigned* st;
};

__device__ __forceinline__ XcdBarrier xcd_barrier_post(unsigned* bar, volatile LAS unsigned* st) {
    XcdBarrier b; b.bar = bar; b.x = xb_xcc_id(); b.st = st;
    if (threadIdx.x == 0) (void)xb_add(&bar[XB_XCNT(b.x)], 1u);
    return b;
}
__device__ __forceinline__ void xcd_barrier_complete(unsigned* bar, unsigned x, unsigned& nloc, unsigned& nx) {
    const unsigned G = gridDim.x * gridDim.y * gridDim.z;
    unsigned sum, cnt, mine, sp = 0u;
    for (;;) {
        sum = 0u; cnt = 0u; mine = 0u;
#pragma unroll
        for (unsigned j = 0; j < 16; ++j) { const unsigned c = xb_ld(&bar[XB_XCNT(j)]); sum += c; cnt += (c > 0u) ? 1u : 0u; mine = (j == x) ? c : mine; }
        if (sum == G) break;
        __builtin_amdgcn_s_sleep(1);
        if ((++sp & 255u) == 0u) { if (xb_ld(&bar[XB_TMO])) break; if (sp > XB_SPIN_CAP) { atomicAdd(&bar[XB_TMO], 1u); break; } }
    }
    nloc = mine > 0u ? mine : 1u; nx = cnt > 0u ? cnt : 1u;
}

__device__ __forceinline__ void xcd_barrier(const XcdBarrier& b) {
    asm volatile("s_waitcnt vmcnt(0)" ::: "memory");
    __syncthreads();
    if (threadIdx.x == 0) {
        unsigned* bar = b.bar;
        __builtin_amdgcn_s_waitcnt(0);
        unsigned nloc = b.st[0], nx = b.st[1];
        if (nloc == 0u) { xcd_barrier_complete(bar, b.x, nloc, nx); b.st[0] = nloc; b.st[1] = nx; }
        const unsigned old = xb_add(&bar[XB_XSUB(b.x)], 1u);
        const unsigned gen = old / nloc;
        if (old + 1u == (gen + 1u) * nloc) {
            __builtin_amdgcn_fence(__ATOMIC_RELEASE, "agent");
            asm volatile("s_waitcnt vmcnt(0)" ::: "memory");
            const unsigned og = xb_add(&bar[XB_TOP], 1u);
            const unsigned tg = og / nx;
            if (og + 1u == (tg + 1u) * nx) xb_add(&bar[XB_TOPGEN], 1u);
            else XB_SPIN(xb_ld(&bar[XB_TOPGEN]) == tg, bar);
            __builtin_amdgcn_fence(__ATOMIC_ACQUIRE, "agent");
            xb_add(&bar[XB_XGEN(b.x)], 1u);
            asm volatile("s_waitcnt vmcnt(0)" ::: "memory");
        } else {
            XB_SPIN(xb_ld(&bar[XB_XGEN(b.x)]) == gen, bar);
            __builtin_amdgcn_fence(__ATOMIC_ACQUIRE, "agent");
            asm volatile("s_waitcnt vmcnt(0)" ::: "memory");
        }
    }
    __syncthreads();
}


__device__ __forceinline__ void run_phase(Ctx& F0, const int p) {
    Ctx F = F0; F.argoff = (unsigned)(uintptr_t)F.lds + ARGS_OFF; asm volatile("" : "+s"(F.G), "+s"(F.vcu), "+s"(F.bx), "+s"(F.argoff));
    unsigned long long wsi_ = (unsigned long long)(uintptr_t)inptr(F, 23); asm volatile("" : "+s"(wsi_));
    unsigned char* ws = (unsigned char*)(__attribute__((address_space(1))) unsigned char*)wsi_;
    F.ws = ws;
    PG8_LAS unsigned char* ldsl = (PG8_LAS unsigned char*)(uintptr_t)(unsigned)(uintptr_t)F.lds;
    if (p == 0) {
#ifndef NO_PRO
        phase_prologue(F);
#endif
        return;
    }
    if (p == 1) {
        phase_xs(F, inptr(F, 0), inptr(F, 2), inptr(F, 6), (const float*)(ws + WS_MOD), STATP(ws, 0, 2), (bf16*)(ws + WS_XN));
        phase_bias(F);
        return;
    }
    if (p == 8) { phase_xs_ctx(F, (float*)(ws + WS_XC), (const float*)(ws + WS_Y), (const float*)(ws + WS_MOD) + (size_t)4 * MODW + 5 * DM, inptr(F, 6) + DM, (const float*)(ws + WS_MOD) + (size_t)5 * MODW, STATP(ws, 1, 2), (bf16*)(ws + WS_XN)); return; }
    if (p == 15) { phase_final(F, (const bf16*)(ws + WS_XR), (float*)inptr(F, 22), inptr(F, 21)); return; }
    const int l = (p >= 9) ? 1 : 0, sub = (p >= 9) ? (p - 8) : (p - 1);
    const bool last = (l == DEPTH - 1);
    const int Mrest = last ? ML : MT;
    if (sub == 1) {
        pg8::Gemm g{(const bf16*)(ws + WS_XN), (const bf16*)(ws + WS_WIN) + (size_t)l * NP * DM}; pg8::StaticOrder S; S.init(MT, NP, F.G, F.bx);
        pg8::EpiWin E{(bf16*)(ws + WS_P), (bf16*)(ws + WS_K), STATP(ws, l, 0), STATP(ws, l, 1), (const float*)(ws + WS_ROPE), STATP(ws, l, 2), (const float*)(ws + WS_B1) + (size_t)l * 5 * NP};
        pg8::gemm_phase<pg8::EpiWin, true, DM, DM, DM>(ldsl, g, S, E);
    } else if (sub == 2) {
        bf16* Pb = (bf16*)(ws + WS_P); bf16* Ob = (bf16*)(ws + WS_O);
#ifndef NO_GQ
        { pg8::Gemm g{Pb + PC_QA, (const bf16*)(ws + WS_WUQ) + (size_t)l * 512 * 256}; pg8::StaticOrder S; S.init(MT, 512, F.G, F.bx);
          pg8::EpiQ E{(bf16*)(ws + WS_Q), STATP(ws, l, 0), (const float*)(ws + WS_ROPE)}; pg8::gemm_phase<pg8::EpiQ, true, 256, NP, 256>(ldsl, g, S, E); }
#endif
#ifndef NO_GKV
        { pg8::Gemm g{Pb + PC_KVA, (const bf16*)(ws + WS_WUKV) + (size_t)l * 512 * 256}; pg8::StaticOrder S; S.init(MT, 512, F.G, F.G - 1 - F.bx);
          pg8::EpiKV E{(bf16*)(ws + WS_K), (bf16*)(ws + WS_V), STATP(ws, l, 1)}; pg8::gemm_phase<pg8::EpiKV, true, 256, NP, 256>(ldsl, g, S, E); }
#endif
        __syncthreads();
#ifndef NO_F1
        for (int rep_ = 0; rep_ < (PROBE_PART == 1 ? 2 : 1); ++rep_) {
        fourier_step1(F, Pb, (bf16*)(ws + WS_Y));
        if (!last) fourier_ctx(F, Pb, Ob);
        __syncthreads(); }
#endif
        __syncthreads();
#ifndef NO_CONV
        for (int rep_ = 0; rep_ < (PROBE_PART == 3 ? 2 : 1); ++rep_)
        { const int nun = last ? 512 : 528;
          const float* wdw = inptr(F, 14) + (size_t)l * 31 * 256; const float* bdw = inptr(F, 15) + l * 256; const float* lng = inptr(F, 16) + l * 256; const float* lnb = inptr(F, 17) + l * 256;
          for (int u = F.vcu; u < nun; u += F.G) {
              if (u < 512) conv_unit(F, Pb, Ob, (u >> 7) * SEQ, SEQ, (u & 127) * 64, wdw, bdw, lng, lnb);
              else { const int v = u - 512; conv_unit(F, Pb, Ob, ML + (v >> 2) * CTXL, CTXL, (v & 3) * 64, wdw, bdw, lng, lnb); }
          } }
#endif
#ifndef NO_NA
        for (int rep_ = 0; rep_ < (PROBE_PART == 2 ? 2 : 1); ++rep_)
        { float* rpb = (float*)(F.lds + MISC_OFF + 2048);
          for (int i = F.tid; i < 4 * 15 * 31; i += NTHR) rpb[i] = inptr(F, 13)[(size_t)l * 4 * 15 * 31 + i];
          __syncthreads();
          for (int u = F.vcu; u < 512; u += F.G) {
              const int bh = u >> 5, rb = u & 31, b = bh >> 2, h = bh & 3, r0 = 4 * rb, rs0 = min(max(r0 - 4, 0), 116);
              att::attn_unit<64, 1, NP, NP, NP>(Pb + (size_t)(b * SEQ + r0 * 64) * NP + PC_NAQ + h * 64, Pb + PC_NAK + h * 64, Pb + PC_NAV + h * 64,
                                    ML + b * CTXL, 4, b * SEQ + rs0 * 64, 16, Ob + (size_t)(b * SEQ + r0 * 64) * DM + 256 + h * 64, F.lds, MISC_OFF + 2048 + h * 15 * 31 * 4, r0, rs0);
          }
          if (!last) for (int u = F.vcu; u < 16; u += F.G) {
              const int b = u >> 2, h = u & 3;
              att::attn_unit<64, 1, NP, NP, NP>(Pb + (size_t)(ML + b * CTXL) * NP + PC_NAQ + h * 64, Pb + PC_NAK + h * 64, Pb + PC_NAV + h * 64,
                                    ML + b * CTXL, 4, 0, 4, Ob + (size_t)(ML + b * CTXL) * DM + 256 + h * 64, F.lds, MISC_OFF + 2048, 0, 0);
          } }
#endif
    } else if (sub == 3) {
        bf16* Qb = (bf16*)(ws + WS_Q); bf16* Kb = (bf16*)(ws + WS_K); bf16* Vb = (bf16*)(ws + WS_V); bf16* Ob = (bf16*)(ws + WS_O);
#ifndef NO_MLA
        for (int u = F.vcu; u < 512; u += F.G) {
            const int bh = u >> 5, qb = u & 31, b = bh >> 2, h = bh & 3;
            att::attn_unit<96, 0, 384, 384, 256>(Qb + (size_t)(b * SEQ + qb * 256) * 384 + h * 96, Kb + h * 96, Vb + h * 64,
                                  b * SEQ, 128, ML + b * CTXL, 132, Ob + (size_t)(b * SEQ + qb * 256) * DM + h * 64, F.lds, 0, 0, 0);
        }
        if (!last) for (int u = F.vcu; u < 16; u += F.G) {
            const int b = u >> 2, h = u & 3;
            att::attn_unit<96, 0, 384, 384, 256>(Qb + (size_t)(ML + b * CTXL) * 384 + h * 96, Kb + h * 96, Vb + h * 64,
                                  ML + b * CTXL, 4, 0, 4, Ob + (size_t)(ML + b * CTXL) * DM + h * 64, F.lds, 0, 0, 0);
        }
#endif
#ifndef NO_F2
        fourier_step2(F, (const bf16*)(ws + WS_Y), Ob);
#endif
    } else if (sub == 4) {
        pg8::Gemm g{(const bf16*)(ws + WS_O), (const bf16*)(ws + WS_WOUT) + (size_t)l * DM * DM}; pg8::StaticOrder S; S.init(Mrest, DM, F.G, F.bx);
        if (l == 0) {
            pg8::EpiRes<false> E{inptr(F, 0), inptr(F, 2), (bf16*)(ws + WS_XR), (float*)(ws + WS_XC), (const float*)(ws + WS_MOD) + (size_t)l * 5 * MODW + 2 * DM,
                                 (bf16*)(ws + WS_XN), STATP(ws, l, 3), inptr(F, 7) + l * DM, (const float*)(ws + WS_MOD) + (size_t)l * 5 * MODW + 4 * DM};
            pg8::gemm_phase<pg8::EpiRes<false>, true, DM, DM, DM>(ldsl, g, S, E);
        } else {
            pg8::EpiRes<true> E{nullptr, nullptr, (bf16*)(ws + WS_XR), nullptr, (const float*)(ws + WS_MOD) + (size_t)l * 5 * MODW + 2 * DM,
                                (bf16*)(ws + WS_XN), STATP(ws, l, 3), inptr(F, 7) + l * DM, (const float*)(ws + WS_MOD) + (size_t)l * 5 * MODW + 4 * DM};
            pg8::gemm_phase<pg8::EpiRes<true>, true, DM, DM, DM>(ldsl, g, S, E);
        }
    } else if (sub == 5) {
        pg8::Gemm g{(const bf16*)(ws + WS_XN), (const bf16*)(ws + WS_W1) + (size_t)l * DM * DFF}; pg8::StaticOrder S; S.init(Mrest, DFF, F.G, F.bx);
        pg8::EpiFF1 E{(bf16*)(ws + WS_H), DFF, STATP(ws, l, 3), (const float*)(ws + WS_B2) + (size_t)l * 5 * DFF};
        pg8::gemm_phase<pg8::EpiFF1, true, DM, DM, DM>(ldsl, g, S, E);
    } else {
        pg8::Gemm g{(const bf16*)(ws + WS_H), (const bf16*)(ws + WS_W2) + (size_t)l * DM * DFF}; pg8::StaticOrder S; S.init(ML, DM, F.G, F.bx);
        pg8::EpiRes<true> E{nullptr, nullptr, (bf16*)(ws + WS_XR), nullptr, (const float*)(ws + WS_MOD) + (size_t)l * 5 * MODW + 5 * DM,
                      last ? (bf16*)nullptr : (bf16*)(ws + WS_XN), STATP(ws, last ? l : l + 1, 2), inptr(F, 6) + (last ? l : l + 1) * DM, (const float*)(ws + WS_MOD) + (size_t)(last ? l : l + 1) * 5 * MODW + DM};
        pg8::gemm_phase<pg8::EpiRes<true>, true, DFF, DFF, DFF>(ldsl, g, S, E);
        if (!last) {
            for (int ks = 0; ks < KSPLIT; ++ks) {
                int c = F.bx - 16 * ks; if (c < 0) c += F.G;
                pg8::EpiPart EA{(float*)(ws + WS_Y) + (size_t)ks * MC * DM};
                pg8::Gemm gk{(const bf16*)(ws + WS_H) + (size_t)ML * DFF + ks * (DFF / KSPLIT), (const bf16*)(ws + WS_W2) + (size_t)l * DM * DFF + ks * (DFF / KSPLIT)}; pg8::StaticOrder Sk; Sk.init(MC, DM, F.G, c);
                pg8::gemm_phase<pg8::EpiPart, true, DFF / KSPLIT, DFF, DFF>(ldsl, gk, Sk, EA);
            }
        }
    }
}

__global__ void __launch_bounds__(NTHR, 2) mk_fwd(Args args) {
    extern __shared__ __attribute__((aligned(16))) unsigned char lds_raw[];
    cg::grid_group grid = cg::this_grid();
    Ctx F; F.lds = (char*)lds_raw; F.tid = threadIdx.x; F.lane = F.tid & 63; F.wave = __builtin_amdgcn_readfirstlane(F.tid >> 6);
    F.G = gridDim.x; F.bx = blockIdx.x; { const int bx = blockIdx.x; F.vcu = (F.G % 8 == 0) ? (bx % 8) * (F.G / 8) + bx / 8 : bx; }
    F.ws = nullptr;
    if (threadIdx.x == 0) {
        unsigned long long* la = (unsigned long long*)(F.lds + ARGS_OFF);
#pragma unroll
        for (int i = 0; i < 22; ++i) la[i] = (unsigned long long)args.in[i];
        la[22] = (unsigned long long)args.out; la[23] = (unsigned long long)args.ws;
    }
    __syncthreads();
    volatile LAS unsigned* bst = (volatile LAS unsigned*)(uintptr_t)((unsigned)(uintptr_t)F.lds + ARGS_OFF + 256);
    if (threadIdx.x < 2) bst[threadIdx.x] = 0u;
    __syncthreads();
    XcdBarrier bar; bar.bar = nullptr; bar.x = 0; bar.st = bst;
    for (int p = args.ph_lo; p < args.ph_hi; ++p) {
        run_phase(F, p);
        if (p + 1 < args.ph_hi) {
            if (p == args.ph_lo) { grid.sync(); bar = xcd_barrier_post((unsigned*)(args.ws + WS_BAR), bst); }
            else xcd_barrier(bar);
        }
    }
}
constexpr int N_PHASES = 16;

extern "C" void kernel_launch(void* const* d_in, const int* in_sizes, int n_in, void* d_out, int out_size, void* d_ws, size_t ws_size, hipStream_t stream) {
    static int grid = 0;
    if (grid == 0) {
        if (n_in != 22 || out_size != ML * DM || ws_size < WS_END) { fprintf(stderr, "kernel_launch: unexpected shapes n_in %d out %d ws %zu (need %zu)\n", n_in, out_size, ws_size, (size_t)WS_END); grid = -1; return; }
        int dev = 0, cus = 0, per_cu = 0;
        hipGetDevice(&dev); hipDeviceGetAttribute(&cus, hipDeviceAttributeMultiprocessorCount, dev);
        if (hipFuncSetAttribute((const void*)mk_fwd, hipFuncAttributeMaxDynamicSharedMemorySize, LDS_BYTES) != hipSuccess) { fprintf(stderr, "kernel_launch: hipFuncSetAttribute failed\n"); grid = -1; return; }
        hipOccupancyMaxActiveBlocksPerMultiprocessor(&per_cu, (const void*)mk_fwd, NTHR, LDS_BYTES);
        if (per_cu < 1) { fprintf(stderr, "kernel_launch: occupancy query says %d blocks per CU\n", per_cu); per_cu = 1; }
        (void)hipGetLastError();
        grid = cus;
    }
    if (grid < 0) return;
    Args a{};
    for (int i = 0; i < 22; ++i) a.in[i] = (const float*)d_in[i];
    a.out = (float*)d_out; a.ws = (unsigned char*)d_ws;
#if MK_MULTI
    for (int p = 0; p < N_PHASES; ++p) {
        a.ph_lo = p; a.ph_hi = p + 1;
        void* args[] = {&a};
        hipError_t e = hipLaunchCooperativeKernel((const void*)mk_fwd, dim3(grid), dim3(NTHR), args, LDS_BYTES, stream);
        if (e != hipSuccess) { fprintf(stderr, "launch %d failed: %s\n", p, hipGetErrorString(e)); break; }
    }
#else
    a.ph_lo = 0; a.ph_hi = N_PHASES;
    void* args[] = {&a};
    hipError_t e = hipLaunchCooperativeKernel((const void*)mk_fwd, dim3(grid), dim3(NTHR), args, LDS_BYTES, stream);
    if (e != hipSuccess) fprintf(stderr, "cooperative launch failed: %s (grid %d)\n", hipGetErrorString(e), grid);
#endif
}
```

```cpp
#include <hip/hip_runtime.h>
#include <hip/hip_cooperative_groups.h>
#include <hip/hip_bf16.h>
#include <cstdio>
#include <cstdint>
namespace cg = cooperative_groups;

#ifndef PROBE_PART
#define PROBE_PART 0
#endif
#ifndef MK_MULTI
#define MK_MULTI 0
#endif

constexpr int DM = 1024, NBATCH = 4, SEQ = 8192, CTXL = 256, DEPTH = 2, DFF = 4096;
constexpr int ML = NBATCH * SEQ, MC = NBATCH * CTXL, MT = ML + MC;
constexpr int D_IN = 1952;
constexpr int NP = 2304;
constexpr int PC_QA = 0, PC_KVA = 256, PC_KR = 384, PC_NAQ = 416, PC_NAK = 672, PC_NAV = 928, PC_ZR = 1184, PC_ZI = 1440, PC_CV = 1696;
constexpr float EPS = 1e-6f;
constexpr int MODW = 6 * DM;

constexpr size_t MiB = 1u << 20;
constexpr size_t WS_MOD = 0;
constexpr size_t WS_ROPE = 248 * 1024;
constexpr size_t WS_B1 = 256 * 1024;
constexpr size_t WS_B2 = 352 * 1024;
constexpr size_t WS_STAT = 512 * 1024;
#define STATP(ws, l, w) ((float*)((ws) + WS_STAT) + (size_t)((l) * 4 + (w)) * MT)
constexpr size_t WS_BAR = 1792 * 1024;
constexpr size_t WS_WIN = 2 * MiB;
constexpr size_t WS_WUQ = 11 * MiB;
constexpr size_t WS_WUKV = 11 * MiB + 512 * 1024;
constexpr size_t WS_WOUT = 12 * MiB;
constexpr size_t WS_W1 = 16 * MiB;
constexpr size_t WS_W2 = 32 * MiB;
constexpr size_t WS_XC = 48 * MiB;
constexpr size_t WS_XN = 52 * MiB;
constexpr size_t WS_Y = 118 * MiB;
constexpr size_t WS_H = 150 * MiB;
constexpr size_t WS_P = 150 * MiB;
constexpr size_t WS_Q = 299 * MiB;
constexpr size_t WS_K = 324 * MiB;
constexpr size_t WS_V = 349 * MiB;
constexpr size_t WS_O = 366 * MiB;
constexpr size_t WS_XR = 432 * MiB;
constexpr size_t WS_END = 496 * MiB;

__device__ __forceinline__ int fresh_tid() { int t = threadIdx.x; asm volatile("" : "+v"(t)); return t; }
namespace pg8 {
#define PG8_LAS __attribute__((address_space(3)))
typedef unsigned short bf16_t;
typedef short bf16x8 __attribute__((ext_vector_type(8)));
typedef float f32x4 __attribute__((ext_vector_type(4)));
typedef float f32x2 __attribute__((ext_vector_type(2)));
typedef unsigned u32x4 __attribute__((ext_vector_type(4)));
typedef unsigned u32x2 __attribute__((ext_vector_type(2)));
constexpr int BM = 256, BK = 64, HALF = 128, HTB = HALF * BK * 2, STAGE_BYTES = 8 * HTB, NXCD = 8, WGM = 8;

__host__ __device__ __forceinline__ int lds_byte(int r, int c) { const int st = (r >> 4) * 2 + (c >> 5), rr = r & 15, cc = c & 31, ob = rr * 64 + cc * 2; return st * 1024 + (ob ^ (((ob >> 9) & 1) << 5)); }
__host__ __device__ __forceinline__ void stage_rc(int b, int& R, int& C) { const int st = b / 1024, sb = b % 1024, swz = sb ^ (((sb >> 9) & 1) << 5); R = (st >> 1) * 16 + swz / 64; C = (st & 1) * 32 + (swz % 64) / 2; }
__host__ __device__ __forceinline__ int perm32(int rho) { const int n = rho >> 4, i = rho & 15; return 8 * (i >> 2) + 4 * n + (i & 3); }

struct Unit { int pm, pn; };
struct Gemm { const bf16_t* A; const bf16_t* Bt; };

struct StaticOrder {
    int nM, nN, nwg, G, c;
    __host__ __device__ void init(int M, int N, int G_, int c_) { nM = M / BM; nN = N / BM; nwg = nM * nN; G = G_; c = c_; }
    __host__ __device__ bool next(int i, Unit& u) const {
        const long L = (long)i * G + c; if (L >= nwg) return false;
        int wgid = (int)L; { const int q = nwg / NXCD, r = nwg % NXCD, xcd = wgid % NXCD, off = wgid / NXCD; wgid = (xcd < r ? xcd * (q + 1) : r * (q + 1) + (xcd - r) * q) + off; }
        const int nig = WGM * nN, gid = wgid / nig, fm = gid * WGM, gsz = (nM - fm) < WGM ? (nM - fm) : WGM;
        u.pm = fm + ((wgid % nig) % gsz); u.pn = (wgid % nig) / gsz; return true;
    }
};

__device__ __forceinline__ unsigned cvt_pk_bf16(float lo, float hi) { unsigned r; asm volatile("v_cvt_pk_bf16_f32 %0, %1, %2" : "=v"(r) : "v"(lo), "v"(hi)); return r; }

template <class Epi, bool ALIGN_EPI, int K, int LDA, int LDB>
__device__ __forceinline__ void gemm_phase(PG8_LAS unsigned char* lds, const Gemm g, const StaticOrder& S, const Epi& E) {
    const int tid = fresh_tid(), wid = __builtin_amdgcn_readfirstlane(tid >> 6), lane = tid & 63, wr = wid >> 2, wc = wid & 3, fr = lane & 15, fq = lane >> 4;
    constexpr int nt = K / BK;
    unsigned voffA[2], voffB[2];
#pragma unroll
    for (int i = 0; i < 2; ++i) { int R, C; stage_rc(tid * 16 + i * 8192, R, C); const int Rb = Epi::PERM ? ((R & ~31) + perm32(R & 31)) : R;
        voffA[i] = (unsigned)(R * LDA + C) * 2u; voffB[i] = (unsigned)(Rb * LDB + C) * 2u; }
    constexpr size_t kstep = (size_t)(BK * 2);
    constexpr size_t hstepA = (size_t)HALF * LDA * 2, hstepB = (size_t)HALF * LDB * 2;
    constexpr size_t tstepA = 2 * hstepA, tstepB = 2 * hstepB;
    const unsigned ldsw = (unsigned)wid * 1024u;
    const int aoff = lds_byte(wr * 64 + fr, fq * 8), boff = lds_byte(wc * 32 + fr, fq * 8);
#define PG8_SA(b, h) (((b) * 2 + (h)) * HTB)
#define PG8_SB(b, h) ((4 + (b) * 2 + (h)) * HTB)
#define PG8_STAGE(bufoff, gbase, voff) do { _Pragma("unroll") for (int _i = 0; _i < 2; ++_i) \
        __builtin_amdgcn_global_load_lds((const unsigned*)((const char*)(gbase) + (voff)[_i]), (PG8_LAS unsigned*)(lds + (bufoff) + ldsw + _i * 8192), 16, 0, 0); } while (0)
#define PG8_LDA(dst, b, h) do { _Pragma("unroll") for (int m = 0; m < 4; ++m) _Pragma("unroll") for (int k = 0; k < 2; ++k) dst[m][k] = *(const PG8_LAS bf16x8*)(lds + PG8_SA(b, h) + aoff + m * 2048 + k * 1024); } while (0)
#define PG8_LDB(dst, b, h) do { _Pragma("unroll") for (int n = 0; n < 2; ++n) _Pragma("unroll") for (int k = 0; k < 2; ++k) dst[n][k] = *(const PG8_LAS bf16x8*)(lds + PG8_SB(b, h) + boff + n * 2048 + k * 1024); } while (0)
#define PG8_MMA(ai, bj, At, Bt) do { __builtin_amdgcn_s_setprio(1); _Pragma("unroll") for (int m = 0; m < 4; ++m) _Pragma("unroll") for (int n = 0; n < 2; ++n) _Pragma("unroll") for (int k = 0; k < 2; ++k) \
        acc[ai][bj][m][n] = __builtin_amdgcn_mfma_f32_16x16x32_bf16(Bt[n][k], At[m][k], acc[ai][bj][m][n], 0, 0, 0); __builtin_amdgcn_s_setprio(0); } while (0)
#define PG8_WAIT_V(n) asm volatile("s_waitcnt vmcnt(" #n ")" ::: "memory")
#define PG8_WAIT_L(n) asm volatile("s_waitcnt lgkmcnt(" #n ")" ::: "memory")
#define PG8_BAR __builtin_amdgcn_s_barrier()
#define PG8_SCHED __builtin_amdgcn_sched_barrier(0)
    Unit cur, nxt; int ui = 0;
    if (!S.next(0, cur)) return;
    f32x4 acc[2][2][4][2];
#pragma unroll
    for (int a = 0; a < 2; ++a)
#pragma unroll
        for (int b = 0; b < 2; ++b)
#pragma unroll
            for (int m = 0; m < 4; ++m)
#pragma unroll
                for (int n = 0; n < 2; ++n) acc[a][b][m][n] = (f32x4){0.f, 0.f, 0.f, 0.f};
    bf16x8 At[4][2], B0[2][2], B1[2][2];
    const char* cA = (const char*)g.A + (size_t)cur.pm * tstepA; const char* cB = (const char*)g.Bt + (size_t)cur.pn * tstepB;
    PG8_STAGE(PG8_SB(0, 0), cB, voffB); PG8_STAGE(PG8_SB(0, 1), cB + hstepB, voffB); PG8_STAGE(PG8_SA(0, 0), cA, voffA); PG8_STAGE(PG8_SA(0, 1), cA + hstepA, voffA);
    if (wr == 1) PG8_BAR;
    PG8_WAIT_V(2); PG8_BAR;
    PG8_STAGE(PG8_SB(1, 0), cB + kstep, voffB); PG8_STAGE(PG8_SA(1, 0), cA + kstep, voffA); PG8_STAGE(PG8_SB(1, 1), cB + hstepB + kstep, voffB);
    PG8_WAIT_V(6); PG8_BAR;
    for (;;) {
        const bool has_next = S.next(ui + 1, nxt);
        const char* nA = has_next ? (const char*)g.A + (size_t)nxt.pm * tstepA : cA; const char* nB = has_next ? (const char*)g.Bt + (size_t)nxt.pn * tstepB : cB;
#pragma unroll 1
        for (int t = 0; t < nt; t += 2) {
            const bool last = (t == nt - 2);
            const char* a1 = cA + (size_t)(t + 1) * kstep;
            const char* a2 = last ? nA : cA + (size_t)(t + 2) * kstep; const char* b2 = last ? nB : cB + (size_t)(t + 2) * kstep;
            const char* a3 = a2 + kstep; const char* b3 = b2 + kstep;
            PG8_LDB(B0, 0, 0); PG8_LDB(B1, 0, 1); PG8_SCHED; PG8_LDA(At, 0, 0); PG8_STAGE(PG8_SA(1, 1), a1 + hstepA, voffA);
            PG8_WAIT_V(8); PG8_WAIT_L(0); PG8_BAR; PG8_MMA(0, 0, At, B0); PG8_MMA(0, 1, At, B1); PG8_BAR; PG8_SCHED;
            PG8_LDA(At, 0, 1); PG8_STAGE(PG8_SB(0, 0), b2, voffB); PG8_STAGE(PG8_SB(0, 1), b2 + hstepB, voffB); PG8_STAGE(PG8_SA(0, 0), a2, voffA);
            PG8_WAIT_V(8); PG8_WAIT_L(0); PG8_BAR; PG8_MMA(1, 0, At, B0); PG8_MMA(1, 1, At, B1); PG8_BAR; PG8_SCHED;
            PG8_LDB(B0, 1, 0); PG8_LDB(B1, 1, 1); PG8_SCHED; PG8_LDA(At, 1, 0); PG8_STAGE(PG8_SA(0, 1), a2 + hstepA, voffA);
            PG8_WAIT_V(8); PG8_WAIT_L(0); PG8_BAR; PG8_MMA(0, 0, At, B0); PG8_MMA(0, 1, At, B1); PG8_BAR; PG8_SCHED;
            PG8_LDA(At, 1, 1); PG8_STAGE(PG8_SB(1, 0), b3, voffB); PG8_STAGE(PG8_SB(1, 1), b3 + hstepB, voffB); PG8_STAGE(PG8_SA(1, 0), a3, voffA);
            PG8_WAIT_V(8); PG8_WAIT_L(0); PG8_BAR; PG8_MMA(1, 0, At, B0); PG8_MMA(1, 1, At, B1); PG8_BAR; PG8_SCHED;
        }
        if constexpr (ALIGN_EPI) { if (wr == 0) PG8_BAR; }
        E(acc, cur, wr, wc, fr, fq);
        if (!has_next) break;
#pragma unroll
        for (int a = 0; a < 2; ++a)
#pragma unroll
            for (int b = 0; b < 2; ++b)
#pragma unroll
                for (int m = 0; m < 4; ++m)
#pragma unroll
                    for (int n = 0; n < 2; ++n) acc[a][b][m][n] = (f32x4){0.f, 0.f, 0.f, 0.f};
        cur = nxt; cA = nA; cB = nB; ++ui;
        if constexpr (ALIGN_EPI) { if (wr == 1) PG8_BAR; }
    }
    PG8_WAIT_V(0);
    if constexpr (!ALIGN_EPI) { if (wr == 0) PG8_BAR; }
    PG8_BAR;
#undef PG8_SA
#undef PG8_SB
#undef PG8_STAGE
#undef PG8_LDA
#undef PG8_LDB
#undef PG8_MMA
#undef PG8_WAIT_V
#undef PG8_WAIT_L
#undef PG8_BAR
#undef PG8_SCHED
}

__device__ __forceinline__ u32x2 pack4(f32x4 v) { u32x2 w; w.x = cvt_pk_bf16(v[0], v[1]); w.y = cvt_pk_bf16(v[2], v[3]); return w; }

struct EpiWin {
    static constexpr bool PERM = false;
    bf16_t* P; bf16_t* Kb; float* ssq; float* sskv; const float* rope; const float* ss1; const float* bias1;
    __device__ __forceinline__ void operator()(const f32x4 (&acc0)[2][2][4][2], const Unit& u, int wr, int wc, int fr, int fq) const {
        const int row0 = u.pm * BM + wr * 64 + fr, colb = u.pn * BM + wc * 32 + 4 * fq;
        const int s = (u.pm < 128) ? (u.pm >> 5) : 4;
        f32x4 bv[2][2];
#pragma unroll
        for (int bj = 0; bj < 2; ++bj)
#pragma unroll
            for (int n = 0; n < 2; ++n) bv[bj][n] = *(const f32x4*)(bias1 + s * NP + colb + bj * HALF + n * 16);
        float rrv[8], ssv[8];
#pragma unroll
        for (int q = 0; q < 8; ++q) { rrv[q] = ss1[row0 + (q >> 2) * HALF + (q & 3) * 16]; ssv[q] = 0.f; }
#pragma unroll
        for (int ai = 0; ai < 2; ++ai)
#pragma unroll
            for (int m = 0; m < 4; ++m) {
                const int row = row0 + ai * HALF + m * 16;
                const float rr = 1.0f / sqrtf(rrv[ai * 4 + m] * (1.0f / DM) + EPS);
                f32x4 acc[2][2][4][2];
#pragma unroll
                for (int bj = 0; bj < 2; ++bj)
#pragma unroll
                    for (int n = 0; n < 2; ++n) acc[ai][bj][m][n] = acc0[ai][bj][m][n] * rr + bv[bj][n];
                bf16_t* rp = P + (size_t)row * NP + colb + ((fq & 1) ? 12 : 0);
#pragma unroll
                for (int bj = 0; bj < 2; ++bj) { const u32x2 wa = pack4(acc[ai][bj][m][0]), wb = pack4(acc[ai][bj][m][1]);
                    const auto r0 = __builtin_amdgcn_permlane16_swap(wa.x, wb.x, false, false); const auto r1 = __builtin_amdgcn_permlane16_swap(wa.y, wb.y, false, false);
                    u32x4 w; w.x = r0[0]; w.y = r1[0]; w.z = r0[1]; w.w = r1[1];
                    *(u32x4*)(rp + bj * HALF) = w; }
                if (u.pn == 0) {
                    float ss = 0.f;
#pragma unroll
                    for (int bj = 0; bj < 2; ++bj)
#pragma unroll
                        for (int n = 0; n < 2; ++n) { const f32x4 v = acc[ai][bj][m][n]; ss += (v[0] * v[0] + v[1] * v[1]) + (v[2] * v[2] + v[3] * v[3]); }
                    ssv[ai * 4 + m] = ss;
                } else if (u.pn == 1) {
                    float ss = 0.f;
#pragma unroll
                    for (int n = 0; n < 2; ++n) { const f32x4 v = acc[ai][0][m][n]; ss += (v[0] * v[0] + v[1] * v[1]) + (v[2] * v[2] + v[3] * v[3]); }
                    ssv[ai * 4 + m] = ss;
                    if (wc == 0) {
                        f32x4 x1 = acc[ai][1][m][0], x2 = acc[ai][1][m][1];
                        if (u.pm < 128) {
                            const int tok = row & (SEQ - 1), pos = (fq < 2) ? (tok >> 6) : (tok & 63);
                            const f32x4 t0 = *(const f32x4*)(rope + pos * 16 + 8 * (fq & 1)), t1 = *(const f32x4*)(rope + pos * 16 + 8 * (fq & 1) + 4);
                            const f32x4 cs = {t0[0], t0[2], t1[0], t1[2]}, sn = {t0[1], t0[3], t1[1], t1[3]};
                            const f32x4 o1 = x1 * cs - x2 * sn, o2 = x1 * sn + x2 * cs; x1 = o1; x2 = o2;
                        }
                        const u32x2 w1 = pack4(x1), w2 = pack4(x2);
#pragma unroll
                        for (int h = 0; h < 4; ++h) { bf16_t* kp = Kb + (size_t)row * 384 + h * 96 + 64 + 4 * fq; *(u32x2*)kp = w1; *(u32x2*)(kp + 16) = w2; }
                    }
                }
            }
        if (u.pn < 2) { float* sp = (u.pn == 0) ? ssq : sskv;
#pragma unroll
            for (int q = 0; q < 8; ++q) { float ss = ssv[q]; ss += __shfl_xor(ss, 16); ss += __shfl_xor(ss, 32); if (fq == 0) atomicAdd(sp + row0 + (q >> 2) * HALF + (q & 3) * 16, ss); } }
    }
};
struct EpiQ {
    static constexpr bool PERM = false;
    bf16_t* Q; const float* ssq; const float* rope;
    __device__ __forceinline__ void operator()(const f32x4 (&acc)[2][2][4][2], const Unit& u, int wr, int wc, int fr, int fq) const {
        const int row0 = u.pm * BM + wr * 64 + fr;
        float rrv[8];
#pragma unroll
        for (int q = 0; q < 8; ++q) rrv[q] = ssq[row0 + (q >> 2) * HALF + (q & 3) * 16];
#pragma unroll
        for (int ai = 0; ai < 2; ++ai)
#pragma unroll
            for (int m = 0; m < 4; ++m) {
                const int row = row0 + ai * HALF + m * 16;
                const float r = 1.0f / sqrtf(rrv[ai * 4 + m] * (1.0f / 256.0f) + EPS);
#pragma unroll
                for (int bj = 0; bj < 2; ++bj) {
                    const int blk = u.pn * 8 + bj * 4 + wc;
                    if (blk < 12) {
                        f32x4 x1 = acc[ai][bj][m][0] * r, x2 = acc[ai][bj][m][1] * r;
                        if ((blk % 3) == 2 && u.pm < 128) {
                            const int tok = row & (SEQ - 1), pos = (fq < 2) ? (tok >> 6) : (tok & 63);
                            const f32x4 t0 = *(const f32x4*)(rope + pos * 16 + 8 * (fq & 1)), t1 = *(const f32x4*)(rope + pos * 16 + 8 * (fq & 1) + 4);
                            const f32x4 cs = {t0[0], t0[2], t1[0], t1[2]}, sn = {t0[1], t0[3], t1[1], t1[3]};
                            const f32x4 o1 = x1 * cs - x2 * sn, o2 = x1 * sn + x2 * cs; x1 = o1; x2 = o2;
                        }
                        bf16_t* qp = Q + (size_t)row * 384 + blk * 32 + 4 * fq;
                        *(u32x2*)qp = pack4(x1); *(u32x2*)(qp + 16) = pack4(x2);
                    }
                }
            }
    }
};
struct EpiKV {
    static constexpr bool PERM = false;
    bf16_t* Kb; bf16_t* Vb; const float* sskv;
    __device__ __forceinline__ void operator()(const f32x4 (&acc)[2][2][4][2], const Unit& u, int wr, int wc, int fr, int fq) const {
        const int row0 = u.pm * BM + wr * 64 + fr;
        float rrv[8];
#pragma unroll
        for (int q = 0; q < 8; ++q) rrv[q] = sskv[row0 + (q >> 2) * HALF + (q & 3) * 16];
#pragma unroll
        for (int ai = 0; ai < 2; ++ai)
#pragma unroll
            for (int m = 0; m < 4; ++m) {
                const int row = row0 + ai * HALF + m * 16;
                const float r = 1.0f / sqrtf(rrv[ai * 4 + m] * (1.0f / 128.0f) + EPS);
#pragma unroll
                for (int bj = 0; bj < 2; ++bj) {
                    const int blk = u.pn * 8 + bj * 4 + wc, h = blk >> 2, w0 = (blk & 3) * 32 + 4 * fq;
                    bf16_t* dp = (w0 < 64) ? (Kb + (size_t)row * 384 + h * 96 + w0) : (Vb + (size_t)row * 256 + h * 64 + (w0 - 64));
                    *(u32x2*)dp = pack4(acc[ai][bj][m][0] * r); *(u32x2*)(dp + 16) = pack4(acc[ai][bj][m][1] * r);
                }
            }
    }
};
template <bool IN_H> struct EpiRes {
    static constexpr bool PERM = false;
    const float* res_lat; const float* res_ctx; bf16_t* xr; float* out_ctx; const float* gate;
    bf16_t* XS; float* ssn; const float* gn; const float* scn;
    __device__ __forceinline__ void operator()(const f32x4 (&acc)[2][2][4][2], const Unit& u, int wr, int wc, int fr, int fq) const {
        const bool lat = IN_H || (u.pm < 128);
        const int s = (u.pm < 128) ? (u.pm >> 5) : 4;
        const int lrow0 = ((u.pm < 128) ? u.pm * BM : (u.pm - 128) * BM) + wr * 64 + fr;
        const int grow0 = u.pm * BM + wr * 64 + fr;
        const int col0 = u.pn * BM + wc * 32 + 4 * fq;
        f32x4 gv[2][2], gs[2][2];
#pragma unroll
        for (int bj = 0; bj < 2; ++bj)
#pragma unroll
            for (int n = 0; n < 2; ++n) { gv[bj][n] = *(const f32x4*)(gate + s * MODW + col0 + bj * HALF + n * 16);
                if (XS) gs[bj][n] = *(const f32x4*)(gn + col0 + bj * HALF + n * 16) * (*(const f32x4*)(scn + s * MODW + col0 + bj * HALF + n * 16) + 1.0f);
                else gs[bj][n] = (f32x4){0.f, 0.f, 0.f, 0.f}; }
        float ssv[8];
        constexpr int GRP = IN_H ? 4 : 2;
#pragma unroll
        for (int pr = 0; pr < 8 / GRP; ++pr) {
            f32x4 pre[IN_H ? 1 : GRP][2][2]; u32x2 preh[IN_H ? GRP : 1][2][2];
#pragma unroll
            for (int mm = 0; mm < GRP; ++mm) { const int q = pr * GRP + mm; const size_t off = (size_t)(lrow0 + (q >> 2) * HALF + (q & 3) * 16) * DM + col0;
#pragma unroll
                for (int bj = 0; bj < 2; ++bj)
#pragma unroll
                    for (int n = 0; n < 2; ++n) {
                        if constexpr (IN_H) preh[mm][bj][n] = *(const u32x2*)(xr + off + bj * HALF + n * 16);
                        else pre[mm][bj][n] = *(const f32x4*)((lat ? res_lat : res_ctx) + off + bj * HALF + n * 16); } }
#pragma unroll
            for (int mm = 0; mm < GRP; ++mm) { const int q = pr * GRP + mm, ai = q >> 2, m = q & 3;
                const size_t off = (size_t)(lrow0 + ai * HALF + m * 16) * DM + col0;
                const size_t goff = (size_t)(grow0 + ai * HALF + m * 16) * DM + col0;
                float ss = 0.f;
#pragma unroll
                for (int bj = 0; bj < 2; ++bj)
#pragma unroll
                    for (int n = 0; n < 2; ++n) { f32x4 rv;
                        if constexpr (IN_H) { const u32x2 w = preh[mm][bj][n]; rv = (f32x4){__builtin_bit_cast(float, w.x << 16), __builtin_bit_cast(float, w.x & 0xffff0000u), __builtin_bit_cast(float, w.y << 16), __builtin_bit_cast(float, w.y & 0xffff0000u)}; }
                        else rv = pre[mm][bj][n];
                        const f32x4 o = rv + gv[bj][n] * acc[ai][bj][m][n];
                        if (lat) *(u32x2*)(xr + off + bj * HALF + n * 16) = pack4(o); else *(f32x4*)(out_ctx + off + bj * HALF + n * 16) = o;
                        if (XS) { ss += (o[0] * o[0] + o[1] * o[1]) + (o[2] * o[2] + o[3] * o[3]); *(u32x2*)(XS + goff + bj * HALF + n * 16) = pack4(o * gs[bj][n]); } }
                ssv[q] = ss;
            }
            asm volatile("" ::: "memory");
        }
        if (XS) {
#pragma unroll
            for (int q = 0; q < 8; ++q) { float ss = ssv[q]; ss += __shfl_xor(ss, 16); ss += __shfl_xor(ss, 32); if (fq == 0) atomicAdd(ssn + grow0 + (q >> 2) * HALF + (q & 3) * 16, ss); } }
    }
};
struct EpiPart {
    static constexpr bool PERM = false;
    float* part;
    __device__ __forceinline__ void operator()(const f32x4 (&acc)[2][2][4][2], const Unit& u, int wr, int wc, int fr, int fq) const {
        const int lrow0 = u.pm * BM + wr * 64 + fr, col0 = u.pn * BM + wc * 32 + 4 * fq;
#pragma unroll
        for (int ai = 0; ai < 2; ++ai)
#pragma unroll
            for (int m = 0; m < 4; ++m) { float* op = part + (size_t)(lrow0 + ai * HALF + m * 16) * DM + col0;
#pragma unroll
                for (int bj = 0; bj < 2; ++bj)
#pragma unroll
                    for (int n = 0; n < 2; ++n) *(f32x4*)(op + bj * HALF + n * 16) = acc[ai][bj][m][n]; }
    }
};
struct EpiFF1 {
    static constexpr bool PERM = true;
    bf16_t* O; int ldc; const float* ss2; const float* bias2;
    __device__ __forceinline__ void operator()(const f32x4 (&acc)[2][2][4][2], const Unit& u, int wr, int wc, int fr, int fq) const {
        const int row0 = u.pm * BM + wr * 64 + fr, col0 = u.pn * BM + wc * 32 + 8 * fq;
        const int s = (u.pm < 128) ? (u.pm >> 5) : 4;
        f32x4 bv[2][2];
#pragma unroll
        for (int bj = 0; bj < 2; ++bj)
#pragma unroll
            for (int n = 0; n < 2; ++n) bv[bj][n] = *(const f32x4*)(bias2 + s * DFF + col0 + bj * HALF + 4 * n);
        float rrv[8];
#pragma unroll
        for (int q = 0; q < 8; ++q) rrv[q] = ss2[row0 + (q >> 2) * HALF + (q & 3) * 16];
#pragma unroll
        for (int ai = 0; ai < 2; ++ai)
#pragma unroll
            for (int m = 0; m < 4; ++m) { const int row = row0 + ai * HALF + m * 16; bf16_t* rowp = O + (size_t)row * ldc + col0;
                const float rr = 1.0f / sqrtf(rrv[ai * 4 + m] * (1.0f / DM) + EPS);
#pragma unroll
                for (int bj = 0; bj < 2; ++bj) { f32x4 v0 = acc[ai][bj][m][0] * rr + bv[bj][0], v1 = acc[ai][bj][m][1] * rr + bv[bj][1];
#pragma unroll
                    for (int j = 0; j < 4; ++j) { const float a = fmaxf(v0[j], 0.f), b = fmaxf(v1[j], 0.f); v0[j] = a * a; v1[j] = b * b; }
                    u32x4 w; w.x = cvt_pk_bf16(v0[0], v0[1]); w.y = cvt_pk_bf16(v0[2], v0[3]); w.z = cvt_pk_bf16(v1[0], v1[1]); w.w = cvt_pk_bf16(v1[2], v1[3]);
                    *(u32x4*)(rowp + bj * HALF) = w; } }
    }
};
}

namespace att {
using bf16x8 = __attribute__((ext_vector_type(8))) short;
using s16x4 = __attribute__((ext_vector_type(4))) short;
using f32x16 = __attribute__((ext_vector_type(16))) float;
using u32x4 = __attribute__((ext_vector_type(4))) unsigned;
typedef unsigned short bf16_t;
constexpr int NW = 8, QBLK = 32, KVBLK = 64;
constexpr float THR = 8.f;
constexpr size_t SHM_V = 16384, SHM_K = 16384, SHM_ATTN = 2 * SHM_V + 2 * SHM_K + NW * 64 * 4;
#define KSWZ(row, colB) ((row) * 256 + ((colB) ^ (((row) & 15) << 4)))
#define SBAR() __builtin_amdgcn_sched_barrier(0)
__device__ __forceinline__ int crow(int r, int hi) { return (r & 3) + 8 * (r >> 2) + 4 * hi; }
__device__ __forceinline__ unsigned cvtpk(float lo, float hi) { unsigned r; asm volatile("v_cvt_pk_bf16_f32 %0, %1, %2" : "=v"(r) : "v"(lo), "v"(hi)); return r; }
__device__ __forceinline__ bf16x8 ld8(const bf16_t* p) { return *reinterpret_cast<const bf16x8*>(p); }

template <int DQK> __device__ __forceinline__ void partialSM(f32x16& p0, f32x16& p1, float& m_reg, float& mn, float& alpha) {
  constexpr float SCALE = (DQK == 96) ? 0.10206207261596577f : 0.125f;
  constexpr float C = SCALE * 1.4426950408889634f;
  float pmax = p0[0];
#pragma unroll
  for (int r = 1; r < 16; ++r) pmax = fmaxf(pmax, p0[r]);
#pragma unroll
  for (int r = 0; r < 16; ++r) pmax = fmaxf(pmax, p1[r]);
  { auto rr = __builtin_amdgcn_permlane32_swap(__float_as_uint(pmax), __float_as_uint(pmax), false, false);
    pmax = fmaxf(__uint_as_float(rr[0]), __uint_as_float(rr[1])); }
  if (__builtin_expect(__all(pmax - m_reg <= THR / SCALE), 1)) { mn = m_reg; alpha = 1.f; }
  else { mn = fmaxf(m_reg, pmax); alpha = __builtin_amdgcn_exp2f((m_reg - mn) * C); m_reg = mn; }
  float mnC = -mn * C;
#pragma unroll
  for (int r = 0; r < 16; ++r) p0[r] = fmaf(p0[r], C, mnC);
#pragma unroll
  for (int r = 0; r < 16; ++r) p1[r] = fmaf(p1[r], C, mnC);
#pragma unroll
  for (int r = 0; r < 16; ++r) p0[r] = __builtin_amdgcn_exp2f(p0[r]);
}
__device__ __forceinline__ void finishSM(f32x16& p0, f32x16& p1, float alpha, float& l_reg, bf16x8& pa0, bf16x8& pa1, bf16x8& pa2, bf16x8& pa3) {
#pragma unroll
  for (int r = 0; r < 16; ++r) p1[r] = __builtin_amdgcn_exp2f(p1[r]);
  float ps = 0;
#pragma unroll
  for (int r = 0; r < 16; ++r) ps += p0[r];
#pragma unroll
  for (int r = 0; r < 16; ++r) ps += p1[r];
  { auto rr = __builtin_amdgcn_permlane32_swap(__float_as_uint(ps), __float_as_uint(ps), false, false);
    ps = __uint_as_float(rr[0]) + __uint_as_float(rr[1]); }
  l_reg = l_reg * alpha + ps;
#define PK4(P, BASE, OUT) do { unsigned a0 = cvtpk(P[BASE + 0], P[BASE + 1]), a1 = cvtpk(P[BASE + 2], P[BASE + 3]);   \
    unsigned b0 = cvtpk(P[BASE + 4], P[BASE + 5]), b1 = cvtpk(P[BASE + 6], P[BASE + 7]);                              \
    auto r0 = __builtin_amdgcn_permlane32_swap(a0, b0, false, false); auto r1 = __builtin_amdgcn_permlane32_swap(a1, b1, false, false); \
    u32x4 w = {r0[0], r1[0], r0[1], r1[1]}; OUT = *reinterpret_cast<bf16x8*>(&w); } while (0)
  PK4(p0, 0, pa0); PK4(p0, 8, pa1); PK4(p1, 0, pa2); PK4(p1, 8, pa3);
#undef PK4
}
template <int DQK> __device__ __forceinline__ void qkt(f32x16& p0, f32x16& p1, const char* Ks, const bf16x8* qr, int r32, int hi) {
  p0 = f32x16{}; p1 = f32x16{};
#pragma unroll
  for (int d0 = 0; d0 < DQK / 16; ++d0) { int cb = (d0 * 16 + hi * 8) * 2;
    bf16x8 b0 = *reinterpret_cast<const bf16x8*>(Ks + KSWZ(r32, cb));
    bf16x8 b1 = *reinterpret_cast<const bf16x8*>(Ks + KSWZ(32 + r32, cb));
    p0 = __builtin_amdgcn_mfma_f32_32x32x16_bf16(b0, qr[d0], p0, 0, 0, 0);
    p1 = __builtin_amdgcn_mfma_f32_32x32x16_bf16(b1, qr[d0], p1, 0, 0, 0); }
}
__device__ __forceinline__ int v_st(int k, int c) { const int kk = (k & ~0xC) | ((k & 4) << 1) | ((k & 8) >> 1); return ((kk >> 3) * 4 + (c >> 5)) * 512 + ((kk & 7) * 32 + (c & 31)) * 2; }
__device__ __forceinline__ int v_rd_base(int lane) { return ((lane & 3) << 3) | (((lane >> 2) & 3) << 6) | (((lane >> 4) & 1) << 5) | (((lane >> 5) & 1) << 8); }
constexpr int v_rd_off(int d0, int ks, int half) { return d0 * 512 + ks * 4096 + half * 2048; }
template <int OFF> __device__ __forceinline__ s16x4 tr_read(int vb) {
  s16x4 r; asm volatile("ds_read_b64_tr_b16 %0, %1 offset:%2" : "=&v"(r) : "v"(vb), "i"(OFF) : "memory"); return r;
}
#define PKLH(L, H) (bf16x8){L[0], L[1], L[2], L[3], H[0], H[1], H[2], H[3]}
template <int D0> __device__ __forceinline__ void pv_one(f32x16& od, int vb, bf16x8 pa0, bf16x8 pa1, bf16x8 pa2, bf16x8 pa3) {
  const s16x4 l0 = tr_read<v_rd_off(D0, 0, 0)>(vb), h0 = tr_read<v_rd_off(D0, 0, 1)>(vb), l1 = tr_read<v_rd_off(D0, 1, 0)>(vb), h1 = tr_read<v_rd_off(D0, 1, 1)>(vb);
  const s16x4 l2 = tr_read<v_rd_off(D0, 2, 0)>(vb), h2 = tr_read<v_rd_off(D0, 2, 1)>(vb), l3 = tr_read<v_rd_off(D0, 3, 0)>(vb), h3 = tr_read<v_rd_off(D0, 3, 1)>(vb);
  asm volatile("s_waitcnt lgkmcnt(0)" ::: "memory"); SBAR();
  od = __builtin_amdgcn_mfma_f32_32x32x16_bf16(pa0, PKLH(l0, h0), od, 0, 0, 0);
  od = __builtin_amdgcn_mfma_f32_32x32x16_bf16(pa1, PKLH(l1, h1), od, 0, 0, 0);
  od = __builtin_amdgcn_mfma_f32_32x32x16_bf16(pa2, PKLH(l2, h2), od, 0, 0, 0);
  od = __builtin_amdgcn_mfma_f32_32x32x16_bf16(pa3, PKLH(l3, h3), od, 0, 0, 0);
}
__device__ __forceinline__ void pv_d0(f32x16* o, int vb, bf16x8 pa0, bf16x8 pa1, bf16x8 pa2, bf16x8 pa3) {
  pv_one<0>(o[0], vb, pa0, pa1, pa2, pa3); pv_one<1>(o[1], vb, pa0, pa1, pa2, pa3);
}
struct NaInfo { const float* brow; int qr, qc; };
__device__ __forceinline__ void na_bias(f32x16& p0, f32x16& p1, const NaInfo& na, int kr, int hi) {
  const int rs = min(max(na.qr - 4, 0), 120);
  if (kr < rs || kr >= rs + 8) {
#pragma unroll
    for (int r = 0; r < 16; ++r) { p0[r] = -1e30f; p1[r] = -1e30f; }
  } else {
    const float* b = na.brow + (kr - na.qr + 7) * 31 + (15 - na.qc) + 4 * hi;
    const int ws = min(max(na.qc - 8, 0), 48) - 4 * hi;
#pragma unroll
    for (int r = 0; r < 16; ++r) {
      const int kc0 = (r & 3) + 8 * (r >> 2);
      const bool ok1 = (unsigned)(kc0 - ws) < 16u, ok2 = (unsigned)(kc0 + 32 - ws) < 16u;
      const float b1 = b[kc0], b2 = b[kc0 + 32];
      p0[r] = ok1 ? p0[r] + 8.0f * b1 : -1e30f;
      p1[r] = ok2 ? p1[r] + 8.0f * b2 : -1e30f;
      if ((r & 3) == 3) SBAR();
    }
  }
}

template <int DQK, int MODE, int ldq, int ldk, int ldv>
__device__ __forceinline__ void attn_unit(const bf16_t* __restrict__ Qb, const bf16_t* __restrict__ Kp, const bf16_t* __restrict__ Vp,
                                          int rowA, int nA, int rowB, int NT, bf16_t* __restrict__ Ob, char* lds, int rpb_off, int r0, int rs0) {
  constexpr int ldo = DM;
  const int tid = fresh_tid(), wid = tid >> 6, lane = tid & 63, r32 = lane & 31, hi = lane >> 5;
  char* V_lds = lds; char* K_lds = lds + 2 * SHM_V;
  float* ws = (float*)(lds + 2 * SHM_V + 2 * SHM_K) + wid * 64; float* li_l = ws; float* al_l = ws + 32;
  float m_reg = -1e30f, l_reg = 0; f32x16 o[2] = {}; bf16x8 qr[DQK / 16];
  const bf16_t* Qw = Qb + (long)(wid * QBLK + r32) * ldq + hi * 8;
#pragma unroll
  for (int d0 = 0; d0 < DQK / 16; ++d0) qr[d0] = ld8(Qw + d0 * 16);
  NaInfo na; na.brow = (const float*)(lds + rpb_off); na.qr = r0 + (wid >> 1); na.qc = (wid & 1) * 32 + r32;
  const int sr = tid >> 3, sc = (tid & 7) * 8, vst0 = v_st(sr, sc), kst0 = KSWZ(sr, sc * 2);
  const int sr2 = (tid & 255) >> 2, sc2 = 64 + (tid & 3) * 8, kst1 = KSWZ(sr2, sc2 * 2);
  const int vb0 = (int)(uintptr_t)V_lds + v_rd_base(lane);
  struct { bf16x8 vs0, ks0, ks1; } sr_[2];
#define KROW(j) (((j) < nA) ? (rowA + (j) * KVBLK) : (rowB + ((j) - nA) * KVBLK))
#define SLOAD(i, j) do { const long kr_ = KROW(j); sr_[i].vs0 = ld8(Vp + (kr_ + sr) * ldv + sc); sr_[i].ks0 = ld8(Kp + (kr_ + sr) * ldk + sc); \
    if (DQK == 96) sr_[i].ks1 = ld8(Kp + (kr_ + sr2) * ldk + sc2); } while (0)
#define SWRITE(b, i) do { *(bf16x8*)(V_lds + (b) * SHM_V + vst0) = sr_[i].vs0; *(bf16x8*)(K_lds + (b) * SHM_K + kst0) = sr_[i].ks0; \
    if (DQK == 96) *(bf16x8*)(K_lds + (b) * SHM_K + kst1) = sr_[i].ks1; } while (0)
#define RESC(a) do { if (__any((a) < 1.f)) { if (hi == 0) al_l[r32] = (a); asm volatile("s_waitcnt lgkmcnt(0)" ::: "memory"); \
    _Pragma("unroll") for (int d = 0; d < 2; ++d) _Pragma("unroll") for (int r = 0; r < 16; ++r) o[d][r] *= al_l[crow(r, hi)]; } } while (0)
#define BIAS(P0, P1, j) do { if (MODE == 1) { SBAR(); if ((j) >= nA) na_bias(P0, P1, na, rs0 + (j) - nA, hi); SBAR(); } } while (0)
  f32x16 pA0, pA1, pB0, pB1; float mnA, mnB, alA, alB; bf16x8 pa0, pa1, pa2, pa3;
  constexpr int SE = 0, SO = 1;
  SLOAD(SE, 0); SLOAD(SO, 1); asm volatile("s_waitcnt vmcnt(0)" ::: "memory"); SWRITE(0, SE); SWRITE(1, SO);
  if (2 < NT) SLOAD(SE, 2);
  __syncthreads();
  qkt<DQK>(pA0, pA1, K_lds, qr, r32, hi); BIAS(pA0, pA1, 0); partialSM<DQK>(pA0, pA1, m_reg, mnA, alA);
  for (int j = 1; j + 1 < NT; j += 2) {
    SBAR(); qkt<DQK>(pB0, pB1, K_lds + SHM_K, qr, r32, hi);
    finishSM(pA0, pA1, alA, l_reg, pa0, pa1, pa2, pa3); SBAR();
    SLOAD(SO, j + 2); SBAR();
    pv_d0(o, vb0, pa0, pa1, pa2, pa3); BIAS(pB0, pB1, j); partialSM<DQK>(pB0, pB1, m_reg, mnB, alB);
    __syncthreads(); SWRITE(0, SE);
    RESC(alB); __syncthreads();
    SBAR(); qkt<DQK>(pA0, pA1, K_lds, qr, r32, hi);
    finishSM(pB0, pB1, alB, l_reg, pa0, pa1, pa2, pa3); SBAR();
    if (j + 3 < NT) SLOAD(SE, j + 3); SBAR();
    pv_d0(o, vb0 + (int)SHM_V, pa0, pa1, pa2, pa3); BIAS(pA0, pA1, j + 1); partialSM<DQK>(pA0, pA1, m_reg, mnA, alA);
    __syncthreads(); SWRITE(1, SO);
    RESC(alA); __syncthreads();
  }
  SBAR(); qkt<DQK>(pB0, pB1, K_lds + SHM_K, qr, r32, hi);
  finishSM(pA0, pA1, alA, l_reg, pa0, pa1, pa2, pa3); SBAR();
  pv_d0(o, vb0, pa0, pa1, pa2, pa3); BIAS(pB0, pB1, NT - 1); partialSM<DQK>(pB0, pB1, m_reg, mnB, alB);
  __syncthreads(); RESC(alB);
  finishSM(pB0, pB1, alB, l_reg, pa0, pa1, pa2, pa3); SBAR();
  pv_d0(o, vb0 + (int)SHM_V, pa0, pa1, pa2, pa3);
  if (hi == 0) li_l[r32] = l_reg; asm volatile("s_waitcnt lgkmcnt(0)" ::: "memory");
  float rli[16];
#pragma unroll
  for (int r = 0; r < 16; ++r) rli[r] = __builtin_amdgcn_rcpf(li_l[crow(r, hi)]);
  bf16_t* Ow = Ob + (long)(wid * QBLK) * ldo;
#pragma unroll
  for (int r = 0; r < 16; ++r) { const int orow = crow(r, hi);
#pragma unroll
    for (int d0 = 0; d0 < 2; ++d0) { const unsigned w = cvtpk(o[d0][r] * rli[r], 0.f); Ow[(long)orow * ldo + d0 * 32 + r32] = (bf16_t)(w & 0xffffu); } }
  __syncthreads();
#undef KROW
#undef SLOAD
#undef SWRITE
#undef RESC
#undef BIAS
}
}

constexpr int NWAVES = 8, NTHR = 512;
constexpr int RING_BYTES = 131072;
constexpr int MISC_OFF = RING_BYTES;
constexpr int LDS_BYTES = 147456;
typedef unsigned short bf16;
typedef unsigned v4u __attribute__((ext_vector_type(4)));
typedef unsigned v2u __attribute__((ext_vector_type(2)));
typedef float f32x4 __attribute__((ext_vector_type(4)));

__device__ __forceinline__ unsigned f2bf(float f) { unsigned u = __builtin_bit_cast(unsigned, f); return (u + 0x7fffu + ((u >> 16) & 1u)) >> 16; }
__device__ __forceinline__ unsigned pk2(float lo, float hi) { return f2bf(lo) | (f2bf(hi) << 16); }
__device__ __forceinline__ float bf2f(unsigned short b) { return __builtin_bit_cast(float, (unsigned)b << 16); }
__device__ __forceinline__ float wave_sum(float v) {
#pragma unroll
    for (int o = 1; o < 64; o <<= 1) v += __shfl_xor(v, o);
    return v;
}
__device__ __forceinline__ float siluf(float x) { return x / (1.0f + __expf(-x)); }

struct Args { const float* in[22]; float* out; unsigned char* ws; int ph_lo, ph_hi; };

struct Ctx {
    char* lds; int tid, lane, wave, vcu, G, bx; unsigned argoff;
    unsigned char* ws;
};

constexpr int ARGS_OFF = MISC_OFF + 12288;
__device__ __forceinline__ const float* inptr(const Ctx& F, int i) {
    const __attribute__((address_space(3))) unsigned* p = (const __attribute__((address_space(3))) unsigned*)(uintptr_t)(F.argoff + 8u * (unsigned)i);
    const unsigned lo = __builtin_amdgcn_readfirstlane(p[0]), hi = __builtin_amdgcn_readfirstlane(p[1]);
    return (const float*)(const __attribute__((address_space(1))) float*)(((unsigned long long)hi << 32) | lo);
}
__device__ __forceinline__ void refresh(Ctx& F) { F.tid = fresh_tid(); F.lane = F.tid & 63; F.wave = __builtin_amdgcn_readfirstlane(F.tid >> 6); }
__device__ __forceinline__ void tr_item(const float* W, int ldw, int ncols, bf16* WT, int ldt, int row_off, float* scr, int item, int lane, const float* kscale) {
    const int nblk = ncols / 32, kb = item / nblk, nb = item % nblk, k0 = 64 * kb, n0 = 32 * nb;
#pragma unroll 8
    for (int i = 0; i < 32; ++i) { const int kk = 2 * i + (lane >> 5); float v = W[(size_t)(k0 + kk) * ldw + n0 + (lane & 31)]; if (kscale) v *= kscale[k0 + kk]; scr[kk * 33 + (lane & 31)] = v; }
    asm volatile("s_waitcnt lgkmcnt(0)" ::: "memory");
    const int c = lane & 7;
#pragma unroll
    for (int j = 0; j < 4; ++j) { const int n = (lane >> 3) + 8 * j; const float* s = scr + (8 * c) * 33 + n;
        v4u o; o.x = pk2(s[0 * 33], s[1 * 33]); o.y = pk2(s[2 * 33], s[3 * 33]); o.z = pk2(s[4 * 33], s[5 * 33]); o.w = pk2(s[6 * 33], s[7 * 33]);
        *(v4u*)(WT + (size_t)(row_off + n0 + n) * ldt + k0 + 8 * c) = o; }
    asm volatile("s_waitcnt lgkmcnt(0)" ::: "memory");
}
__device__ __forceinline__ void fz_item(const float* Win, bf16* WinT, const float* tab64, int item, int lane) {
    const int part = item & 1, mb = (item >> 1) & 7, g = (item >> 4) & 3, kb = item >> 6, k0 = 64 * kb;
    f32x4 wr[16];
    const float* rowp = Win + (size_t)(k0 + lane) * D_IN + 1184 + 64 * g;
#pragma unroll
    for (int i = 0; i < 16; ++i) wr[i] = *(const f32x4*)(rowp + 4 * i);
    const int sh = part ? 48 : 0;
    for (int mm = 0; mm < 8; ++mm) {
        const int m = mb * 8 + mm; float acc = 0.f;
#pragma unroll
        for (int c = 0; c < 64; ++c) { const int t = (m * c + sh) & 63; acc += wr[c >> 2][c & 3] * tab64[t]; }
        WinT[(size_t)((part ? PC_ZI : PC_ZR) + 64 * g + m) * DM + k0 + lane] = (bf16)f2bf(acc);
    }
}

__device__ __forceinline__ void phase_prologue(Ctx& F) {
    refresh(F);
    unsigned char* ws = F.ws;
    float* mod = (float*)(ws + WS_MOD);
    const int tid = F.tid, lane = F.lane, wave = F.wave;
    float* tab64 = (float*)(F.lds + MISC_OFF);
    if (tid < 64) tab64[tid] = __builtin_amdgcn_cosf((float)tid * (1.0f / 64.0f));
    if (F.bx < 192) {
        float* sl = (float*)F.lds; float* red = (float*)(F.lds + 32768);
        for (int i = tid; i < 5 * DM; i += NTHR) { const int s = i >> 10, k = i & 1023; sl[i] = siluf(s < 4 ? inptr(F, 1)[s * DM + k] : inptr(F, 3)[k]); }
        __syncthreads();
        for (int item = F.bx; item < 192; item += F.G) {
            const int l = item / 96, j0 = (item % 96) * 64, cl = tid & 63, ks = tid >> 6;
            const float* wm = inptr(F, 4) + ((size_t)l * DM + ks * 128) * MODW + j0 + cl;
            float a0 = 0, a1 = 0, a2 = 0, a3 = 0, a4 = 0;
            for (int k8 = 0; k8 < 128; k8 += 16) { float w[16];
#pragma unroll
                for (int q = 0; q < 16; ++q) w[q] = wm[(size_t)(k8 + q) * MODW];
#pragma unroll
                for (int q = 0; q < 16; ++q) { const int kk = ks * 128 + k8 + q;
                    a0 += sl[kk] * w[q]; a1 += sl[1024 + kk] * w[q]; a2 += sl[2048 + kk] * w[q]; a3 += sl[3072 + kk] * w[q]; a4 += sl[4096 + kk] * w[q]; } }
            red[(ks * 5 + 0) * 64 + cl] = a0; red[(ks * 5 + 1) * 64 + cl] = a1; red[(ks * 5 + 2) * 64 + cl] = a2; red[(ks * 5 + 3) * 64 + cl] = a3; red[(ks * 5 + 4) * 64 + cl] = a4;
            __syncthreads();
            if (tid < 320) { const int s = tid >> 6; float v = inptr(F, 5)[l * MODW + j0 + cl];
                for (int q = 0; q < 8; ++q) v += red[(q * 5 + s) * 64 + cl];
                mod[(size_t)(l * 5 + s) * MODW + j0 + cl] = v; }
            __syncthreads();
        }
    }
    __syncthreads();
    if (F.bx == F.G - 1) {
        float* rope = (float*)(ws + WS_ROPE);
        for (int i = tid; i < 1024; i += NTHR) { const int pos = i >> 3, f = i & 7; const float inv = exp2f(-(float)f * (13.287712379549449f / 8.0f));
            const float rev = (float)pos * inv * 0.15915494309189535f; rope[2 * i] = __builtin_amdgcn_cosf(rev); rope[2 * i + 1] = __builtin_amdgcn_sinf(rev); }
    }
    if (F.bx == 0) { unsigned* bw = (unsigned*)(ws + WS_BAR); for (int i = tid; i < 3456; i += NTHR) bw[i] = 0u; }
    const int gt = F.bx * NTHR + tid, GT = F.G * NTHR;
    { float* z = (float*)(ws + WS_STAT); for (int i = gt; i < 8 * MT; i += GT) z[i] = 0.f; }
    for (int l = 0; l < 2; ++l) {
        v4u zz = {0u, 0u, 0u, 0u};
        bf16* wi = (bf16*)(ws + WS_WIN) + (size_t)l * NP * DM + (size_t)2208 * DM;
        for (int i = gt; i < 96 * DM / 8; i += GT) *(v4u*)(wi + (size_t)i * 8) = zz;
        bf16* wq = (bf16*)(ws + WS_WUQ) + (size_t)l * 512 * 256 + (size_t)384 * 256;
        for (int i = gt; i < 128 * 256 / 8; i += GT) *(v4u*)(wq + (size_t)i * 8) = zz;
        bf16* wk = (bf16*)(ws + WS_WUKV) + (size_t)l * 512 * 256;
        for (int i = gt; i < 512 * 16; i += GT) *(v4u*)(wk + (size_t)(i >> 4) * 256 + 128 + (i & 15) * 8) = zz;
    }
    float* scr = (float*)(F.lds + wave * 16384);
    const int gw = F.vcu * NWAVES + wave, NGW = F.G * NWAVES;
    constexpr int I_A = 16 * 37, I_B = 16 * 16, I_Q = 4 * 12, I_KV = 2 * 16, I_O = 16 * 32, I_1 = 16 * 128, I_2 = 64 * 32, I_FZ = 1024;
    constexpr int I_L = I_A + I_B + I_Q + I_KV + I_O + I_1 + I_2 + I_FZ;
    for (int it = gw; it < 2 * I_L; it += NGW) {
        const int l = it / I_L; int r = it % I_L;
        const float* win = inptr(F, 8) + (size_t)l * DM * D_IN; bf16* winT = (bf16*)(ws + WS_WIN) + (size_t)l * NP * DM;
        if (r < I_A) { tr_item(win, D_IN, 1184, winT, DM, 0, scr, r, lane, nullptr); continue; } r -= I_A;
        if (r < I_B) { tr_item(win + 1440, D_IN, 512, winT, DM, PC_CV, scr, r, lane, nullptr); continue; } r -= I_B;
        if (r < I_Q) { tr_item(inptr(F, 10) + (size_t)l * 256 * 384, 384, 384, (bf16*)(ws + WS_WUQ) + (size_t)l * 512 * 256, 256, 0, scr, r, lane, inptr(F, 9) + l * 256); continue; } r -= I_Q;
        if (r < I_KV) { tr_item(inptr(F, 12) + (size_t)l * 128 * 512, 512, 512, (bf16*)(ws + WS_WUKV) + (size_t)l * 512 * 256, 256, 0, scr, r, lane, inptr(F, 11) + l * 128); continue; } r -= I_KV;
        if (r < I_O) { tr_item(inptr(F, 18) + (size_t)l * DM * DM, DM, DM, (bf16*)(ws + WS_WOUT) + (size_t)l * DM * DM, DM, 0, scr, r, lane, nullptr); continue; } r -= I_O;
        if (r < I_1) { tr_item(inptr(F, 19) + (size_t)l * DM * DFF, DFF, DFF, (bf16*)(ws + WS_W1) + (size_t)l * DM * DFF, DM, 0, scr, r, lane, nullptr); continue; } r -= I_1;
        if (r < I_2) { tr_item(inptr(F, 20) + (size_t)l * DFF * DM, DM, DM, (bf16*)(ws + WS_W2) + (size_t)l * DM * DFF, DFF, 0, scr, r, lane, nullptr); continue; } r -= I_2;
        fz_item(win, winT, tab64, r, lane);
    }
}

__device__ __forceinline__ void phase_xs(Ctx& F, const float* xlat, const float* xctx, const float* g, const float* modl, float* ss1, bf16* XS) {
    refresh(F);
    const int gw = F.vcu * NWAVES + F.wave, NGW = F.G * NWAVES, lane = F.lane;
    for (int row0 = 2 * gw; row0 < MT; row0 += 2 * NGW) {
        f32x4 v[2][4]; float ss[2] = {0.f, 0.f};
#pragma unroll
        for (int q = 0; q < 2; ++q) { const int row = row0 + q;
            const float* xr = row < ML ? xlat + (size_t)row * DM : xctx + (size_t)(row - ML) * DM;
#pragma unroll
            for (int j = 0; j < 4; ++j) v[q][j] = __builtin_nontemporal_load((const f32x4*)(xr + 256 * j + 4 * lane)); }
#pragma unroll
        for (int q = 0; q < 2; ++q) { const int row = row0 + q; const int s = row < ML ? (row >> 13) : 4;
            const float* sc = modl + s * MODW + DM;
#pragma unroll
            for (int j = 0; j < 4; ++j) ss[q] += (v[q][j][0] * v[q][j][0] + v[q][j][1] * v[q][j][1]) + (v[q][j][2] * v[q][j][2] + v[q][j][3] * v[q][j][3]);
            ss[q] = wave_sum(ss[q]);
            if (lane == 0) ss1[row] = ss[q];
#pragma unroll
            for (int j = 0; j < 4; ++j) { const int c = 256 * j + 4 * lane;
                const f32x4 gg = *(const f32x4*)(g + c), s1 = *(const f32x4*)(sc + c);
                const f32x4 y = v[q][j] * gg * (s1 + 1.0f);
                v2u w; w.x = pk2(y[0], y[1]); w.y = pk2(y[2], y[3]); *(v2u*)(XS + (size_t)row * DM + c) = w; } }
    }
}
constexpr int KSPLIT = 8;
__device__ __forceinline__ void phase_xs_ctx(Ctx& F, float* xctx, const float* part, const float* gate4, const float* g, const float* modl, float* ss1, bf16* XS) {
    refresh(F);
    const int gw = F.vcu * NWAVES + F.wave, NGW = F.G * NWAVES, lane = F.lane;
    for (int r = gw; r < MC; r += NGW) {
        const int row = ML + r;
        float* xr = xctx + (size_t)r * DM; const float* sc = modl + 4 * MODW + DM;
        f32x4 v[4]; float ss = 0.f;
#pragma unroll
        for (int j = 0; j < 4; ++j) { const int c = 256 * j + 4 * lane; f32x4 a = {0.f, 0.f, 0.f, 0.f};
#pragma unroll
            for (int ks = 0; ks < KSPLIT; ++ks) a += *(const f32x4*)(part + ((size_t)ks * MC + r) * DM + c);
            v[j] = *(const f32x4*)(xr + c) + *(const f32x4*)(gate4 + c) * a; *(f32x4*)(xr + c) = v[j];
            ss += (v[j][0] * v[j][0] + v[j][1] * v[j][1]) + (v[j][2] * v[j][2] + v[j][3] * v[j][3]); }
        ss = wave_sum(ss);
        if (lane == 0) ss1[row] = ss;
#pragma unroll
        for (int j = 0; j < 4; ++j) { const int c = 256 * j + 4 * lane;
            const f32x4 gg = *(const f32x4*)(g + c), s1 = *(const f32x4*)(sc + c);
            const f32x4 y = v[j] * gg * (s1 + 1.0f);
            v2u w; w.x = pk2(y[0], y[1]); w.y = pk2(y[2], y[3]); *(v2u*)(XS + (size_t)row * DM + c) = w; }
    }
}
__device__ __forceinline__ void phase_bias(Ctx& F) {
    refresh(F);
    unsigned char* ws = F.ws;
    const int gw = F.vcu * NWAVES + F.wave, NGW = F.G * NWAVES, lane = F.lane;
    for (int grp = 0; grp < 4; ++grp) {
        const int l = grp >> 1, which = grp & 1, nrows = which ? DFF : NP;
        const float* shb = (const float*)(ws + WS_MOD) + (size_t)l * 5 * MODW + (which ? 3 * DM : 0) + 16 * lane;
        const bf16* W = which ? (const bf16*)(ws + WS_W1) + (size_t)l * DM * DFF : (const bf16*)(ws + WS_WIN) + (size_t)l * NP * DM;
        float* outp = which ? (float*)(ws + WS_B2) + (size_t)l * 5 * DFF : (float*)(ws + WS_B1) + (size_t)l * 5 * NP;
        for (int n0 = gw; n0 < nrows; n0 += 2 * NGW) {
            const int n1 = n0 + NGW; const bool h1 = n1 < nrows; const int n1c = h1 ? n1 : n0;
            const v4u wa0 = *(const v4u*)(W + (size_t)n0 * DM + 16 * lane), wa1 = *(const v4u*)(W + (size_t)n0 * DM + 16 * lane + 8);
            const v4u wb0 = *(const v4u*)(W + (size_t)n1c * DM + 16 * lane), wb1 = *(const v4u*)(W + (size_t)n1c * DM + 16 * lane + 8);
            float fa[16], fb[16];
#pragma unroll
            for (int q = 0; q < 4; ++q) { fa[2 * q] = __builtin_bit_cast(float, wa0[q] << 16); fa[2 * q + 1] = __builtin_bit_cast(float, wa0[q] & 0xffff0000u);
                fa[8 + 2 * q] = __builtin_bit_cast(float, wa1[q] << 16); fa[8 + 2 * q + 1] = __builtin_bit_cast(float, wa1[q] & 0xffff0000u);
                fb[2 * q] = __builtin_bit_cast(float, wb0[q] << 16); fb[2 * q + 1] = __builtin_bit_cast(float, wb0[q] & 0xffff0000u);
                fb[8 + 2 * q] = __builtin_bit_cast(float, wb1[q] << 16); fb[8 + 2 * q + 1] = __builtin_bit_cast(float, wb1[q] & 0xffff0000u); }
#pragma unroll
            for (int sI = 0; sI < 5; ++sI) { float a = 0.f, b = 0.f;
#pragma unroll
                for (int q = 0; q < 4; ++q) { const f32x4 hv = *(const f32x4*)(shb + sI * MODW + 4 * q);
                    a += (hv[0] * fa[4 * q] + hv[1] * fa[4 * q + 1]) + (hv[2] * fa[4 * q + 2] + hv[3] * fa[4 * q + 3]);
                    b += (hv[0] * fb[4 * q] + hv[1] * fb[4 * q + 1]) + (hv[2] * fb[4 * q + 2] + hv[3] * fb[4 * q + 3]); }
                a = wave_sum(a); b = wave_sum(b);
                if (lane == 0) { outp[sI * nrows + n0] = a; if (h1) outp[sI * nrows + n1] = b; } }
        }
    }
}
__device__ __forceinline__ void phase_final(Ctx& F, const bf16* xr, float* out, const float* g) {
    refresh(F);
    const int gw = F.vcu * NWAVES + F.wave, NGW = F.G * NWAVES, lane = F.lane;
    f32x4 gg[4];
#pragma unroll
    for (int j = 0; j < 4; ++j) gg[j] = *(const f32x4*)(g + 256 * j + 4 * lane);
    for (int row0 = 4 * gw; row0 < ML; row0 += 4 * NGW) {
        v2u w[4][4];
#pragma unroll
        for (int q = 0; q < 4; ++q)
#pragma unroll
            for (int j = 0; j < 4; ++j) w[q][j] = *(const v2u*)(xr + (size_t)(row0 + q) * DM + 256 * j + 4 * lane);
#pragma unroll
        for (int q = 0; q < 4; ++q) { f32x4 v[4]; float ss = 0.f;
#pragma unroll
            for (int j = 0; j < 4; ++j) { v[j] = (f32x4){__builtin_bit_cast(float, w[q][j].x << 16), __builtin_bit_cast(float, w[q][j].x & 0xffff0000u), __builtin_bit_cast(float, w[q][j].y << 16), __builtin_bit_cast(float, w[q][j].y & 0xffff0000u)};
                ss += (v[j][0] * v[j][0] + v[j][1] * v[j][1]) + (v[j][2] * v[j][2] + v[j][3] * v[j][3]); }
            const float r = 1.0f / sqrtf(wave_sum(ss) * (1.0f / DM) + EPS);
#pragma unroll
            for (int j = 0; j < 4; ++j) __builtin_nontemporal_store(v[j] * r * gg[j], (f32x4*)(out + (size_t)(row0 + q) * DM + 256 * j + 4 * lane)); }
    }
}

__device__ __forceinline__ void conv_unit(Ctx& F, const bf16* P, bf16* O, int seq_row0, int seq_len, int t0, const float* wdw, const float* bdw, const float* lng, const float* lnb) {
    refresh(F);
    float* y = (float*)F.lds;
    const int tid = F.tid;
    {
        v4u av[6], gv[6]; bool okv[6];
#pragma unroll
        for (int q = 0; q < 6; ++q) { const int i = tid + q * NTHR, r = i >> 5, c8 = (i & 31) * 8, t = t0 - 15 + r;
            okv[q] = (i < 94 * 32) && t >= 0 && t < seq_len;
            const bf16* pr = P + (size_t)(seq_row0 + (okv[q] ? t : 0)) * NP + PC_CV + c8;
            av[q] = okv[q] ? *(const v4u*)pr : (v4u){0u, 0u, 0u, 0u}; gv[q] = okv[q] ? *(const v4u*)(pr + 256) : (v4u){0u, 0u, 0u, 0u}; }
#pragma unroll
        for (int q = 0; q < 6; ++q) { const int i = tid + q * NTHR, r = i >> 5, c8 = (i & 31) * 8;
            float o[8];
#pragma unroll
            for (int w = 0; w < 4; ++w) { const unsigned aw = av[q][w], gw = gv[q][w];
                const float a0 = __builtin_bit_cast(float, aw << 16), a1 = __builtin_bit_cast(float, aw & 0xffff0000u), g0 = __builtin_bit_cast(float, gw << 16), g1 = __builtin_bit_cast(float, gw & 0xffff0000u);
                o[2 * w] = okv[q] ? a0 / (1.0f + __expf(-g0)) : 0.f; o[2 * w + 1] = okv[q] ? a1 / (1.0f + __expf(-g1)) : 0.f; }
            if (i < 94 * 32) { *(f32x4*)(y + r * 256 + c8) = (f32x4){o[0], o[1], o[2], o[3]}; *(f32x4*)(y + r * 256 + c8 + 4) = (f32x4){o[4], o[5], o[6], o[7]}; } }
    }
    __syncthreads();
    const int c = tid & 255, hf = tid >> 8;
    float w[31];
#pragma unroll
    for (int k = 0; k < 31; ++k) w[k] = wdw[k * 256 + c];
    const float bb = bdw[c];
    float outv[32];
#pragma unroll
    for (int tt = 0; tt < 32; ++tt) { float a = bb; const float* yp = y + (hf * 32 + tt) * 256 + c;
#pragma unroll
        for (int k = 0; k < 31; ++k) a += w[k] * yp[k * 256];
        outv[tt] = a; }
    __syncthreads();
#pragma unroll
    for (int tt = 0; tt < 32; ++tt) y[(hf * 32 + tt) * 256 + c] = outv[tt];
    __syncthreads();
    const int lane = F.lane, wave = F.wave;
    const f32x4 gg = *(const f32x4*)(lng + 4 * lane), be = *(const f32x4*)(lnb + 4 * lane);
    for (int q = 0; q < 8; ++q) {
        const int tt = wave * 8 + q;
        const f32x4 v = *(const f32x4*)(y + tt * 256 + 4 * lane);
        const float mu = wave_sum((v[0] + v[1]) + (v[2] + v[3])) * (1.0f / 256.0f);
        const f32x4 d = v - mu;
        const float var = wave_sum((d[0] * d[0] + d[1] * d[1]) + (d[2] * d[2] + d[3] * d[3])) * (1.0f / 256.0f);
        const float rs = 1.0f / sqrtf(var + EPS);
        f32x4 o = d * rs * gg + be;
#pragma unroll
        for (int j = 0; j < 4; ++j) o[j] = siluf(o[j]);
        v2u wv; wv.x = pk2(o[0], o[1]); wv.y = pk2(o[2], o[3]);
        *(v2u*)(O + (size_t)(seq_row0 + t0 + tt) * DM + 768 + 4 * lane) = wv;
    }
    __syncthreads();
}

__device__ __forceinline__ void fourier_step1(Ctx& F, const bf16* P, bf16* Y) {
    refresh(F);
    using namespace att;
    const int tid = F.tid, lane = F.lane, wave = F.wave, r32 = lane & 31, hi = lane >> 5;
    bf16x8 afr[16];
    { const int k1 = 16 * wave + (r32 & 15); const bool isV = r32 >= 16;
#pragma unroll
      for (int s = 0; s < 16; ++s) {
        unsigned wv[4];
#pragma unroll
        for (int i2 = 0; i2 < 4; ++i2) { float e[2];
#pragma unroll
            for (int q = 0; q < 2; ++q) { const int kk = 16 * s + 8 * hi + 2 * i2 + q, part = kk >> 7, n1 = kk & 127; const int t = (k1 * n1) & 127;
                const float cs = __builtin_amdgcn_cosf((float)t * (1.0f / 128.0f)), sn = __builtin_amdgcn_sinf((float)t * (1.0f / 128.0f));
                e[q] = isV ? (part ? cs : sn) : (part ? -sn : cs); }
            wv[i2] = pk2(e[0], e[1]); }
        u32x4 w = {wv[0], wv[1], wv[2], wv[3]}; afr[s] = *reinterpret_cast<bf16x8*>(&w);
      } }
    char* img = F.lds;
    const int vb = (int)(uintptr_t)img + v_rd_base(lane);
    for (int prob = F.vcu; prob < 256; prob += F.G) {
        const int b = prob >> 6, n2 = prob & 63;
        for (int ch = 0; ch < 2; ++ch) {
#pragma unroll
            for (int q = 0; q < 8; ++q) { const int idx = q * NTHR + tid, kb = idx >> 10, k = (idx >> 4) & 63, c = (idx & 15) * 8;
                const int part = kb >> 1, n1 = (kb & 1) * 64 + k;
                const bf16x8 v = ld8(P + (size_t)(b * SEQ + 64 * n1 + n2) * NP + (part ? PC_ZI : PC_ZR) + 128 * ch + c);
                *(bf16x8*)(img + kb * 16384 + v_st(k, c)) = v; }
            __syncthreads();
#define F1_Q(Q, D0) do { \
                const s16x4 l0 = tr_read<(Q) * 16384 + v_rd_off(D0, 0, 0)>(vb), h0 = tr_read<(Q) * 16384 + v_rd_off(D0, 0, 1)>(vb), l1 = tr_read<(Q) * 16384 + v_rd_off(D0, 1, 0)>(vb), h1 = tr_read<(Q) * 16384 + v_rd_off(D0, 1, 1)>(vb); \
                const s16x4 l2 = tr_read<(Q) * 16384 + v_rd_off(D0, 2, 0)>(vb), h2 = tr_read<(Q) * 16384 + v_rd_off(D0, 2, 1)>(vb), l3 = tr_read<(Q) * 16384 + v_rd_off(D0, 3, 0)>(vb), h3 = tr_read<(Q) * 16384 + v_rd_off(D0, 3, 1)>(vb); \
                asm volatile("s_waitcnt lgkmcnt(0)" ::: "memory"); SBAR(); \
                acc = __builtin_amdgcn_mfma_f32_32x32x16_bf16(afr[4 * (Q) + 0], PKLH(l0, h0), acc, 0, 0, 0); acc = __builtin_amdgcn_mfma_f32_32x32x16_bf16(afr[4 * (Q) + 1], PKLH(l1, h1), acc, 0, 0, 0); \
                acc = __builtin_amdgcn_mfma_f32_32x32x16_bf16(afr[4 * (Q) + 2], PKLH(l2, h2), acc, 0, 0, 0); acc = __builtin_amdgcn_mfma_f32_32x32x16_bf16(afr[4 * (Q) + 3], PKLH(l3, h3), acc, 0, 0, 0); } while (0)
#define F1_D0(D0) do { f32x16 acc = {}; \
            F1_Q(0, D0); F1_Q(1, D0); F1_Q(2, D0); F1_Q(3, D0); \
            const int col = 128 * ch + 32 * (D0) + r32; \
            _Pragma("unroll") for (int r = 0; r < 8; ++r) { const int k1 = 16 * wave + crow(r, hi); const float rev = (float)(k1 * n2) * (1.0f / 8192.0f); \
                const float cb = __builtin_amdgcn_cosf(rev), sb = __builtin_amdgcn_sinf(rev); const float U = acc[r], V = acc[r + 8]; \
                bf16* yp = Y + ((size_t)((b * 128 + k1) * 2) * 64 + n2) * 256 + col; \
                yp[0] = (bf16)f2bf(U * cb - V * sb); yp[(size_t)64 * 256] = (bf16)f2bf(U * sb + V * cb); } } while (0)
            F1_D0(0); F1_D0(1); F1_D0(2); F1_D0(3);
#undef F1_D0
#undef F1_Q
            __syncthreads();
        }
    }
}
__device__ __forceinline__ void fourier_step2(Ctx& F, const bf16* Y, bf16* O) {
    refresh(F);
    using namespace att;
    const int tid = F.tid, lane = F.lane, wave = F.wave, r32 = lane & 31, hi = lane >> 5;
    bf16x8 afr[2][8];
#pragma unroll
    for (int mt = 0; mt < 2; ++mt)
#pragma unroll
      for (int s = 0; s < 8; ++s) { const int k2 = 32 * mt + r32;
        unsigned wv[4];
#pragma unroll
        for (int i2 = 0; i2 < 4; ++i2) { float e[2];
#pragma unroll
            for (int q = 0; q < 2; ++q) { const int kk = 16 * s + 8 * hi + 2 * i2 + q, part = kk >> 6, n2 = kk & 63; const int t = (k2 * n2) & 63;
                e[q] = part ? -__builtin_amdgcn_sinf((float)t * (1.0f / 64.0f)) : __builtin_amdgcn_cosf((float)t * (1.0f / 64.0f)); }
            wv[i2] = pk2(e[0], e[1]); }
        u32x4 w = {wv[0], wv[1], wv[2], wv[3]}; afr[mt][s] = *reinterpret_cast<bf16x8*>(&w); }
    char* img = F.lds;
    const int ch = wave >> 2, d0 = wave & 3;
    const int vb = (int)(uintptr_t)img + v_rd_base(lane) + ch * 32768 + d0 * 512;
    const float scale = 0.0013810679320049757f;
    for (int prob = F.vcu; prob < 512; prob += F.G) {
        const int b = prob >> 7, k1 = prob & 127;
        const bf16* src = Y + (size_t)((b * 128 + k1) * 2) * 64 * 256;
#pragma unroll
        for (int q = 0; q < 8; ++q) { const int idx = q * NTHR + tid, key = idx >> 5, c = (idx & 31) * 8;
            const bf16x8 v = ld8(src + (size_t)key * 256 + c);
            *(bf16x8*)(img + (c >> 7) * 32768 + (key >> 6) * 16384 + v_st(key & 63, c & 127)) = v; }
        __syncthreads();
        f32x16 acc0 = {}, acc1 = {};
#define F2_S(S, KB, KS) do { const s16x4 lo = tr_read<(KB) * 16384 + v_rd_off(0, KS, 0)>(vb), hh = tr_read<(KB) * 16384 + v_rd_off(0, KS, 1)>(vb); \
            asm volatile("s_waitcnt lgkmcnt(0)" ::: "memory"); SBAR(); const bf16x8 bb = PKLH(lo, hh); \
            acc0 = __builtin_amdgcn_mfma_f32_32x32x16_bf16(afr[0][S], bb, acc0, 0, 0, 0); acc1 = __builtin_amdgcn_mfma_f32_32x32x16_bf16(afr[1][S], bb, acc1, 0, 0, 0); } while (0)
        F2_S(0, 0, 0); F2_S(1, 0, 1); F2_S(2, 0, 2); F2_S(3, 0, 3); F2_S(4, 1, 0); F2_S(5, 1, 1); F2_S(6, 1, 2); F2_S(7, 1, 3);
#undef F2_S
        const int col = 512 + 32 * wave + r32;
#pragma unroll
        for (int r = 0; r < 16; ++r) { const int k2 = crow(r, hi);
            O[(size_t)(b * SEQ + k1 + 128 * k2) * DM + col] = (bf16)f2bf(acc0[r] * scale);
            O[(size_t)(b * SEQ + k1 + 128 * (k2 + 32)) * DM + col] = (bf16)f2bf(acc1[r] * scale); }
        __syncthreads();
    }
}
__device__ __forceinline__ void fourier_ctx(Ctx& F, const bf16* P, bf16* O) {
    refresh(F);
    float* tab = (float*)(F.lds + MISC_OFF + 512);
    const int tid = F.tid;
    if (tid < 256) tab[tid] = __builtin_amdgcn_cosf((float)tid * (1.0f / 256.0f));
    __syncthreads();
    const int col = tid & 255, kh = tid >> 8;
    for (int item = F.vcu; item < 256; item += F.G) {
        const int b = item >> 6, kq = (item & 63) * 4 + kh * 2;
        float a0 = 0.f, a1 = 0.f;
        const bf16* src = P + (size_t)(ML + b * CTXL) * NP;
        for (int n8 = 0; n8 < 256; n8 += 8) {
            unsigned short zr_[8], zi_[8];
#pragma unroll
            for (int q = 0; q < 8; ++q) { zr_[q] = src[(size_t)(n8 + q) * NP + PC_ZR + col]; zi_[q] = src[(size_t)(n8 + q) * NP + PC_ZI + col]; }
#pragma unroll
            for (int q = 0; q < 8; ++q) { const int n = n8 + q; const float zr = bf2f(zr_[q]), zi = bf2f(zi_[q]);
                const int i0 = (kq * n) & 255, i1 = ((kq + 1) * n) & 255;
                a0 += zr * tab[i0] - zi * tab[(i0 + 192) & 255];
                a1 += zr * tab[i1] - zi * tab[(i1 + 192) & 255]; }
        }
        O[(size_t)(ML + b * CTXL + kq) * DM + 512 + col] = (bf16)f2bf(a0 * (1.0f / 128.0f));
        O[(size_t)(ML + b * CTXL + kq + 1) * DM + 512 + col] = (bf16)f2bf(a1 * (1.0f / 128.0f));
    }
}

#define LAS __attribute__((address_space(3)))
#define XB_TMO      128
#define XB_XCNT(j)  (256  + 64 * (j))
#define XB_XSUB(j)  (1280 + 64 * (j))
#define XB_XGEN(j)  (2304 + 64 * (j))
#define XB_TOP      3328
#define XB_TOPGEN   3392
#define XCD_BAR_WORDS 3456
#define XB_SPIN_CAP (1u << 18)

__device__ __forceinline__ unsigned xb_ld(unsigned* p)              { return __hip_atomic_load(p, __ATOMIC_RELAXED, __HIP_MEMORY_SCOPE_AGENT); }
__device__ __forceinline__ unsigned xb_add(unsigned* p, unsigned v) { return __hip_atomic_fetch_add(p, v, __ATOMIC_RELAXED, __HIP_MEMORY_SCOPE_AGENT); }
__device__ __forceinline__ unsigned xb_xcc_id() { return (unsigned)__builtin_amdgcn_s_getreg((3 << 11) | 20) & 0xFu; }
#define XB_SPIN(cond, bar) do { unsigned _sp = 0; while (cond) { __builtin_amdgcn_s_sleep(1); \
    if ((++_sp & 255u) == 0u) { if (xb_ld(&(bar)[XB_TMO])) break; if (_sp > XB_SPIN_CAP) { atomicAdd(&(bar)[XB_TMO], 1u); break; } } } } while (0)

struct XcdBarrier {
    unsigned* bar; unsigned x;
    volatile LAS unsigned* st;
};

__device__ __forceinline__ XcdBarrier xcd_barrier_post(unsigned* bar, volatile LAS unsigned* st) {
    XcdBarrier b; b.bar = bar; b.x = xb_xcc_id(); b.st = st;
    if (threadIdx.x == 0) (void)xb_add(&bar[XB_XCNT(b.x)], 1u);
    return b;
}
__device__ __forceinline__ void xcd_barrier_complete(unsigned* bar, unsigned x, unsigned& nloc, unsigned& nx) {
    const unsigned G = gridDim.x * gridDim.y * gridDim.z;
    unsigned sum, cnt, mine, sp = 0u;
    for (;;) {
        sum = 0u; cnt = 0u; mine = 0u;
#pragma unroll
        for (unsigned j = 0; j < 16; ++j) { const unsigned c = xb_ld(&bar[XB_XCNT(j)]); sum += c; cnt += (c > 0u) ? 1u : 0u; mine = (j == x) ? c : mine; }
        if (sum == G) break;
        __builtin_amdgcn_s_sleep(1);
        if ((++sp & 255u) == 0u) { if (xb_ld(&bar[XB_TMO])) break; if (sp > XB_SPIN_CAP) { atomicAdd(&bar[XB_TMO], 1u); break; } }
    }
    nloc = mine > 0u ? mine : 1u; nx = cnt > 0u ? cnt : 1u;
}

__device__ __forceinline__ void xcd_barrier(const XcdBarrier& b) {
    asm volatile("s_waitcnt vmcnt(0)" ::: "memory");
    __syncthreads();
    if (threadIdx.x == 0) {
        unsigned* bar = b.bar;
        __builtin_amdgcn_s_waitcnt(0);
        unsigned nloc = b.st[0], nx = b.st[1];
        if (nloc == 0u) { xcd_barrier_complete(bar, b.x, nloc, nx); b.st[0] = nloc; b.st[1] = nx; }
        const unsigned old = xb_add(&bar[XB_XSUB(b.x)], 1u);
        const unsigned gen = old / nloc;
        if (old + 1u == (gen + 1u) * nloc) {
            __builtin_amdgcn_fence(__ATOMIC_RELEASE, "agent");
            asm volatile("s_waitcnt vmcnt(0)" ::: "memory");
            const unsigned og = xb_add(&bar[XB_TOP], 1u);
            const unsigned tg = og / nx;
            if (og + 1u == (tg + 1u) * nx) xb_add(&bar[XB_TOPGEN], 1u);
            else XB_SPIN(xb_ld(&bar[XB_TOPGEN]) == tg, bar);
            __builtin_amdgcn_fence(__ATOMIC_ACQUIRE, "agent");
            xb_add(&bar[XB_XGEN(b.x)], 1u);
            asm volatile("s_waitcnt vmcnt(0)" ::: "memory");
        } else {
            XB_SPIN(xb_ld(&bar[XB_XGEN(b.x)]) == gen, bar);
            __builtin_amdgcn_fence(__ATOMIC_ACQUIRE, "agent");
            asm volatile("s_waitcnt vmcnt(0)" ::: "memory");
        }
    }
    __syncthreads();
}


__device__ __forceinline__ void run_phase(Ctx& F0, const int p) {
    Ctx F = F0; F.argoff = (unsigned)(uintptr_t)F.lds + ARGS_OFF; asm volatile("" : "+s"(F.G), "+s"(F.vcu), "+s"(F.bx), "+s"(F.argoff));
    unsigned long long wsi_ = (unsigned long long)(uintptr_t)inptr(F, 23); asm volatile("" : "+s"(wsi_));
    unsigned char* ws = (unsigned char*)(__attribute__((address_space(1))) unsigned char*)wsi_;
    F.ws = ws;
    PG8_LAS unsigned char* ldsl = (PG8_LAS unsigned char*)(uintptr_t)(unsigned)(uintptr_t)F.lds;
    if (p == 0) {
#ifndef NO_PRO
        phase_prologue(F);
#endif
        return;
    }
    if (p == 1) {
        phase_xs(F, inptr(F, 0), inptr(F, 2), inptr(F, 6), (const float*)(ws + WS_MOD), STATP(ws, 0, 2), (bf16*)(ws + WS_XN));
        phase_bias(F);
        return;
    }
    if (p == 8) { phase_xs_ctx(F, (float*)(ws + WS_XC), (const float*)(ws + WS_Y), (const float*)(ws + WS_MOD) + (size_t)4 * MODW + 5 * DM, inptr(F, 6) + DM, (const float*)(ws + WS_MOD) + (size_t)5 * MODW, STATP(ws, 1, 2), (bf16*)(ws + WS_XN)); return; }
    if (p == 15) { phase_final(F, (const bf16*)(ws + WS_XR), (float*)inptr(F, 22), inptr(F, 21)); return; }
    const int l = (p >= 9) ? 1 : 0, sub = (p >= 9) ? (p - 8) : (p - 1);
    const bool last = (l == DEPTH - 1);
    const int Mrest = last ? ML : MT;
    if (sub == 1) {
        pg8::Gemm g{(const bf16*)(ws + WS_XN), (const bf16*)(ws + WS_WIN) + (size_t)l * NP * DM}; pg8::StaticOrder S; S.init(MT, NP, F.G, F.bx);
        pg8::EpiWin E{(bf16*)(ws + WS_P), (bf16*)(ws + WS_K), STATP(ws, l, 0), STATP(ws, l, 1), (const float*)(ws + WS_ROPE), STATP(ws, l, 2), (const float*)(ws + WS_B1) + (size_t)l * 5 * NP};
        pg8::gemm_phase<pg8::EpiWin, true, DM, DM, DM>(ldsl, g, S, E);
    } else if (sub == 2) {
        bf16* Pb = (bf16*)(ws + WS_P); bf16* Ob = (bf16*)(ws + WS_O);
#ifndef NO_GQ
        { pg8::Gemm g{Pb + PC_QA, (const bf16*)(ws + WS_WUQ) + (size_t)l * 512 * 256}; pg8::StaticOrder S; S.init(MT, 512, F.G, F.bx);
          pg8::EpiQ E{(bf16*)(ws + WS_Q), STATP(ws, l, 0), (const float*)(ws + WS_ROPE)}; pg8::gemm_phase<pg8::EpiQ, true, 256, NP, 256>(ldsl, g, S, E); }
#endif
#ifndef NO_GKV
        { pg8::Gemm g{Pb + PC_KVA, (const bf16*)(ws + WS_WUKV) + (size_t)l * 512 * 256}; pg8::StaticOrder S; S.init(MT, 512, F.G, F.G - 1 - F.bx);
          pg8::EpiKV E{(bf16*)(ws + WS_K), (bf16*)(ws + WS_V), STATP(ws, l, 1)}; pg8::gemm_phase<pg8::EpiKV, true, 256, NP, 256>(ldsl, g, S, E); }
#endif
        __syncthreads();
#ifndef NO_F1
        for (int rep_ = 0; rep_ < (PROBE_PART == 1 ? 2 : 1); ++rep_) {
        fourier_step1(F, Pb, (bf16*)(ws + WS_Y));
        if (!last) fourier_ctx(F, Pb, Ob);
        __syncthreads(); }
#endif
        __syncthreads();
#ifndef NO_CONV
        for (int rep_ = 0; rep_ < (PROBE_PART == 3 ? 2 : 1); ++rep_)
        { const int nun = last ? 512 : 528;
          const float* wdw = inptr(F, 14) + (size_t)l * 31 * 256; const float* bdw = inptr(F, 15) + l * 256; const float* lng = inptr(F, 16) + l * 256; const float* lnb = inptr(F, 17) + l * 256;
          for (int u = F.vcu; u < nun; u += F.G) {
              if (u < 512) conv_unit(F, Pb, Ob, (u >> 7) * SEQ, SEQ, (u & 127) * 64, wdw, bdw, lng, lnb);
              else { const int v = u - 512; conv_unit(F, Pb, Ob, ML + (v >> 2) * CTXL, CTXL, (v & 3) * 64, wdw, bdw, lng, lnb); }
          } }
#endif
#ifndef NO_NA
        for (int rep_ = 0; rep_ < (PROBE_PART == 2 ? 2 : 1); ++rep_)
        { float* rpb = (float*)(F.lds + MISC_OFF + 2048);
          for (int i = F.tid; i < 4 * 15 * 31; i += NTHR) rpb[i] = inptr(F, 13)[(size_t)l * 4 * 15 * 31 + i];
          __syncthreads();
          for (int u = F.vcu; u < 512; u += F.G) {
              const int bh = u >> 5, rb = u & 31, b = bh >> 2, h = bh & 3, r0 = 4 * rb, rs0 = min(max(r0 - 4, 0), 116);
              att::attn_unit<64, 1, NP, NP, NP>(Pb + (size_t)(b * SEQ + r0 * 64) * NP + PC_NAQ + h * 64, Pb + PC_NAK + h * 64, Pb + PC_NAV + h * 64,
                                    ML + b * CTXL, 4, b * SEQ + rs0 * 64, 16, Ob + (size_t)(b * SEQ + r0 * 64) * DM + 256 + h * 64, F.lds, MISC_OFF + 2048 + h * 15 * 31 * 4, r0, rs0);
          }
          if (!last) for (int u = F.vcu; u < 16; u += F.G) {
              const int b = u >> 2, h = u & 3;
              att::attn_unit<64, 1, NP, NP, NP>(Pb + (size_t)(ML + b * CTXL) * NP + PC_NAQ + h * 64, Pb + PC_NAK + h * 64, Pb + PC_NAV + h * 64,
                                    ML + b * CTXL, 4, 0, 4, Ob + (size_t)(ML + b * CTXL) * DM + 256 + h * 64, F.lds, MISC_OFF + 2048, 0, 0);
          } }
#endif
    } else if (sub == 3) {
        bf16* Qb = (bf16*)(ws + WS_Q); bf16* Kb = (bf16*)(ws + WS_K); bf16* Vb = (bf16*)(ws + WS_V); bf16* Ob = (bf16*)(ws + WS_O);
#ifndef NO_MLA
        for (int u = F.vcu; u < 512; u += F.G) {
            const int bh = u >> 5, qb = u & 31, b = bh >> 2, h = bh & 3;
            att::attn_unit<96, 0, 384, 384, 256>(Qb + (size_t)(b * SEQ + qb * 256) * 384 + h * 96, Kb + h * 96, Vb + h * 64,
                                  b * SEQ, 128, ML + b * CTXL, 132, Ob + (size_t)(b * SEQ + qb * 256) * DM + h * 64, F.lds, 0, 0, 0);
        }
        if (!last) for (int u = F.vcu; u < 16; u += F.G) {
            const int b = u >> 2, h = u & 3;
            att::attn_unit<96, 0, 384, 384, 256>(Qb + (size_t)(ML + b * CTXL) * 384 + h * 96, Kb + h * 96, Vb + h * 64,
                                  ML + b * CTXL, 4, 0, 4, Ob + (size_t)(ML + b * CTXL) * DM + h * 64, F.lds, 0, 0, 0);
        }
#endif
#ifndef NO_F2
        fourier_step2(F, (const bf16*)(ws + WS_Y), Ob);
#endif
    } else if (sub == 4) {
        pg8::Gemm g{(const bf16*)(ws + WS_O), (const bf16*)(ws + WS_WOUT) + (size_t)l * DM * DM}; pg8::StaticOrder S; S.init(Mrest, DM, F.G, F.bx);
        if (l == 0) {
            pg8::EpiRes<false> E{inptr(F, 0), inptr(F, 2), (bf16*)(ws + WS_XR), (float*)(ws + WS_XC), (const float*)(ws + WS_MOD) + (size_t)l * 5 * MODW + 2 * DM,
                                 (bf16*)(ws + WS_XN), STATP(ws, l, 3), inptr(F, 7) + l * DM, (const float*)(ws + WS_MOD) + (size_t)l * 5 * MODW + 4 * DM};
            pg8::gemm_phase<pg8::EpiRes<false>, true, DM, DM, DM>(ldsl, g, S, E);
        } else {
            pg8::EpiRes<true> E{nullptr, nullptr, (bf16*)(ws + WS_XR), nullptr, (const float*)(ws + WS_MOD) + (size_t)l * 5 * MODW + 2 * DM,
                                (bf16*)(ws + WS_XN), STATP(ws, l, 3), inptr(F, 7) + l * DM, (const float*)(ws + WS_MOD) + (size_t)l * 5 * MODW + 4 * DM};
            pg8::gemm_phase<pg8::EpiRes<true>, true, DM, DM, DM>(ldsl, g, S, E);
        }
    } else if (sub == 5) {
        pg8::Gemm g{(const bf16*)(ws + WS_XN), (const bf16*)(ws + WS_W1) + (size_t)l * DM * DFF}; pg8::StaticOrder S; S.init(Mrest, DFF, F.G, F.bx);
        pg8::EpiFF1 E{(bf16*)(ws + WS_H), DFF, STATP(ws, l, 3), (const float*)(ws + WS_B2) + (size_t)l * 5 * DFF};
        pg8::gemm_phase<pg8::EpiFF1, true, DM, DM, DM>(ldsl, g, S, E);
    } else {
        pg8::Gemm g{(const bf16*)(ws + WS_H), (const bf16*)(ws + WS_W2) + (size_t)l * DM * DFF}; pg8::StaticOrder S; S.init(ML, DM, F.G, F.bx);
        pg8::EpiRes<true> E{nullptr, nullptr, (bf16*)(ws + WS_XR), nullptr, (const float*)(ws + WS_MOD) + (size_t)l * 5 * MODW + 5 * DM,
                      last ? (bf16*)nullptr : (bf16*)(ws + WS_XN), STATP(ws, last ? l : l + 1, 2), inptr(F, 6) + (last ? l : l + 1) * DM, (const float*)(ws + WS_MOD) + (size_t)(last ? l : l + 1) * 5 * MODW + DM};
        pg8::gemm_phase<pg8::EpiRes<true>, true, DFF, DFF, DFF>(ldsl, g, S, E);
        if (!last) {
            for (int ks = 0; ks < KSPLIT; ++ks) {
                int c = F.bx - 16 * ks; if (c < 0) c += F.G;
                pg8::EpiPart EA{(float*)(ws + WS_Y) + (size_t)ks * MC * DM};
                pg8::Gemm gk{(const bf16*)(ws + WS_H) + (size_t)ML * DFF + ks * (DFF / KSPLIT), (const bf16*)(ws + WS_W2) + (size_t)l * DM * DFF + ks * (DFF / KSPLIT)}; pg8::StaticOrder Sk; Sk.init(MC, DM, F.G, c);
                pg8::gemm_phase<pg8::EpiPart, true, DFF / KSPLIT, DFF, DFF>(ldsl, gk, Sk, EA);
            }
        }
    }
}

__global__ void __launch_bounds__(NTHR, 2) mk_fwd(Args args) {
    extern __shared__ __attribute__((aligned(16))) unsigned char lds_raw[];
    cg::grid_group grid = cg::this_grid();
    Ctx F; F.lds = (char*)lds_raw; F.tid = threadIdx.x; F.lane = F.tid & 63; F.wave = __builtin_amdgcn_readfirstlane(F.tid >> 6);
    F.G = gridDim.x; F.bx = blockIdx.x; { const int bx = blockIdx.x; F.vcu = (F.G % 8 == 0) ? (bx % 8) * (F.G / 8) + bx / 8 : bx; }
    F.ws = nullptr;
    if (threadIdx.x == 0) {
        unsigned long long* la = (unsigned long long*)(F.lds + ARGS_OFF);
#pragma unroll
        for (int i = 0; i < 22; ++i) la[i] = (unsigned long long)args.in[i];
        la[22] = (unsigned long long)args.out; la[23] = (unsigned long long)args.ws;
    }
    __syncthreads();
    volatile LAS unsigned* bst = (volatile LAS unsigned*)(uintptr_t)((unsigned)(uintptr_t)F.lds + ARGS_OFF + 256);
    if (threadIdx.x < 2) bst[threadIdx.x] = 0u;
    __syncthreads();
    XcdBarrier bar; bar.bar = nullptr; bar.x = 0; bar.st = bst;
    for (int p = args.ph_lo; p < args.ph_hi; ++p) {
        run_phase(F, p);
        if (p + 1 < args.ph_hi) {
            if (p == args.ph_lo) { grid.sync(); bar = xcd_barrier_post((unsigned*)(args.ws + WS_BAR), bst); }
            else xcd_barrier(bar);
        }
    }
}
constexpr int N_PHASES = 16;

extern "C" void kernel_launch(void* const* d_in, const int* in_sizes, int n_in, void* d_out, int out_size, void* d_ws, size_t ws_size, hipStream_t stream) {
    static int grid = 0;
    if (grid == 0) {
        if (n_in != 22 || out_size != ML * DM || ws_size < WS_END) { fprintf(stderr, "kernel_launch: unexpected shapes n_in %d out %d ws %zu (need %zu)\n", n_in, out_size, ws_size, (size_t)WS_END); grid = -1; return; }
        int dev = 0, cus = 0, per_cu = 0;
        hipGetDevice(&dev); hipDeviceGetAttribute(&cus, hipDeviceAttributeMultiprocessorCount, dev);
        if (hipFuncSetAttribute((const void*)mk_fwd, hipFuncAttributeMaxDynamicSharedMemorySize, LDS_BYTES) != hipSuccess) { fprintf(stderr, "kernel_launch: hipFuncSetAttribute failed\n"); grid = -1; return; }
        hipOccupancyMaxActiveBlocksPerMultiprocessor(&per_cu, (const void*)mk_fwd, NTHR, LDS_BYTES);
        if (per_cu < 1) { fprintf(stderr, "kernel_launch: occupancy query says %d blocks per CU\n", per_cu); per_cu = 1; }
        (void)hipGetLastError();
        grid = cus;
    }
    if (grid < 0) return;
    Args a{};
    for (int i = 0; i < 22; ++i) a.in[i] = (const float*)d_in[i];
    a.out = (float*)d_out; a.ws = (unsigned char*)d_ws;
#if MK_MULTI
    for (int p = 0; p < N_PHASES; ++p) {
        a.ph_lo = p; a.ph_hi = p + 1;
        void* args[] = {&a};
        hipError_t e = hipLaunchCooperativeKernel((const void*)mk_fwd, dim3(grid), dim3(NTHR), args, LDS_BYTES, stream);
        if (e != hipSuccess) { fprintf(stderr, "launch %d failed: %s\n", p, hipGetErrorString(e)); break; }
    }
#else
    a.ph_lo = 0; a.ph_hi = N_PHASES;
    void* args[] = {&a};
    hipError_t e = hipLaunchCooperativeKernel((const void*)mk_fwd, dim3(grid), dim3(NTHR), args, LDS_BYTES, stream);
    if (e != hipSuccess) fprintf(stderr, "cooperative launch failed: %s (grid %d)\n", hipGetErrorString(e), grid);
#endif
}
```

```cpp
#include <hip/hip_runtime.h>
#include <hip/hip_cooperative_groups.h>
#include <hip/hip_bf16.h>
#include <cstdio>
#include <cstdint>
namespace cg = cooperative_groups;

#ifndef PROBE_PART
#define PROBE_PART 0
#endif
#ifndef MK_MULTI
#define MK_MULTI 0
#endif

constexpr int DM = 1024, NBATCH = 4, SEQ = 8192, CTXL = 256, DEPTH = 2, DFF = 4096;
constexpr int ML = NBATCH * SEQ, MC = NBATCH * CTXL, MT = ML + MC;
constexpr int D_IN = 1952;
constexpr int NP = 2304;
constexpr int PC_QA = 0, PC_KVA = 256, PC_KR = 384, PC_NAQ = 416, PC_NAK = 672, PC_NAV = 928, PC_ZR = 1184, PC_ZI = 1440, PC_CV = 1696;
constexpr float EPS = 1e-6f;
constexpr int MODW = 6 * DM;

constexpr size_t MiB = 1u << 20;
constexpr size_t WS_MOD = 0;
constexpr size_t WS_ROPE = 248 * 1024;
constexpr size_t WS_B1 = 256 * 1024;
constexpr size_t WS_B2 = 352 * 1024;
constexpr size_t WS_STAT = 512 * 1024;
#define STATP(ws, l, w) ((float*)((ws) + WS_STAT) + (size_t)((l) * 4 + (w)) * MT)
constexpr size_t WS_BAR = 1792 * 1024;
constexpr size_t WS_WIN = 2 * MiB;
constexpr size_t WS_WUQ = 11 * MiB;
constexpr size_t WS_WUKV = 11 * MiB + 512 * 1024;
constexpr size_t WS_WOUT = 12 * MiB;
constexpr size_t WS_W1 = 16 * MiB;
constexpr size_t WS_W2 = 32 * MiB;
constexpr size_t WS_XC = 48 * MiB;
constexpr size_t WS_XN = 52 * MiB;
constexpr size_t WS_Y = 118 * MiB;
constexpr size_t WS_H = 150 * MiB;
constexpr size_t WS_P = 150 * MiB;
constexpr size_t WS_Q = 299 * MiB;
constexpr size_t WS_K = 324 * MiB;
constexpr size_t WS_V = 349 * MiB;
constexpr size_t WS_O = 366 * MiB;
constexpr size_t WS_XR = 432 * MiB;
constexpr size_t WS_END = 496 * MiB;

__device__ __forceinline__ int fresh_tid() { int t = threadIdx.x; asm volatile("" : "+v"(t)); return t; }
namespace pg8 {
#define PG8_LAS __attribute__((address_space(3)))
typedef unsigned short bf16_t;
typedef short bf16x8 __attribute__((ext_vector_type(8)));
typedef float f32x4 __attribute__((ext_vector_type(4)));
typedef float f32x2 __attribute__((ext_vector_type(2)));
typedef unsigned u32x4 __attribute__((ext_vector_type(4)));
typedef unsigned u32x2 __attribute__((ext_vector_type(2)));
constexpr int BM = 256, BK = 64, HALF = 128, HTB = HALF * BK * 2, STAGE_BYTES = 8 * HTB, NXCD = 8, WGM = 8;

__host__ __device__ __forceinline__ int lds_byte(int r, int c) { const int st = (r >> 4) * 2 + (c >> 5), rr = r & 15, cc = c & 31, ob = rr * 64 + cc * 2; return st * 1024 + (ob ^ (((ob >> 9) & 1) << 5)); }
__host__ __device__ __forceinline__ void stage_rc(int b, int& R, int& C) { const int st = b / 1024, sb = b % 1024, swz = sb ^ (((sb >> 9) & 1) << 5); R = (st >> 1) * 16 + swz / 64; C = (st & 1) * 32 + (swz % 64) / 2; }
__host__ __device__ __forceinline__ int perm32(int rho) { const int n = rho >> 4, i = rho & 15; return 8 * (i >> 2) + 4 * n + (i & 3); }

struct Unit { int pm, pn; };
struct Gemm { const bf16_t* A; const bf16_t* Bt; };

struct StaticOrder {
    int nM, nN, nwg, G, c;
    __host__ __device__ void init(int M, int N, int G_, int c_) { nM = M / BM; nN = N / BM; nwg = nM * nN; G = G_; c = c_; }
    __host__ __device__ bool next(int i, Unit& u) const {
        const long L = (long)i * G + c; if (L >= nwg) return false;
        int wgid = (int)L; { const int q = nwg / NXCD, r = nwg % NXCD, xcd = wgid % NXCD, off = wgid / NXCD; wgid = (xcd < r ? xcd * (q + 1) : r * (q + 1) + (xcd - r) * q) + off; }
        const int nig = WGM * nN, gid = wgid / nig, fm = gid * WGM, gsz = (nM - fm) < WGM ? (nM - fm) : WGM;
        u.pm = fm + ((wgid % nig) % gsz); u.pn = (wgid % nig) / gsz; return true;
    }
};

__device__ __forceinline__ unsigned cvt_pk_bf16(float lo, float hi) { unsigned r; asm volatile("v_cvt_pk_bf16_f32 %0, %1, %2" : "=v"(r) : "v"(lo), "v"(hi)); return r; }

template <class Epi, bool ALIGN_EPI, int K, int LDA, int LDB>
__device__ __forceinline__ void gemm_phase(PG8_LAS unsigned char* lds, const Gemm g, const StaticOrder& S, const Epi& E) {
    const int tid = fresh_tid(), wid = __builtin_amdgcn_readfirstlane(tid >> 6), lane = tid & 63, wr = wid >> 2, wc = wid & 3, fr = lane & 15, fq = lane >> 4;
    constexpr int nt = K / BK;
    unsigned voffA[2], voffB[2];
#pragma unroll
    for (int i = 0; i < 2; ++i) { int R, C; stage_rc(tid * 16 + i * 8192, R, C); const int Rb = Epi::PERM ? ((R & ~31) + perm32(R & 31)) : R;
        voffA[i] = (unsigned)(R * LDA + C) * 2u; voffB[i] = (unsigned)(Rb * LDB + C) * 2u; }
    constexpr size_t kstep = (size_t)(BK * 2);
    constexpr size_t hstepA = (size_t)HALF * LDA * 2, hstepB = (size_t)HALF * LDB * 2;
    constexpr size_t tstepA = 2 * hstepA, tstepB = 2 * hstepB;
    const unsigned ldsw = (unsigned)wid * 1024u;
    const int aoff = lds_byte(wr * 64 + fr, fq * 8), boff = lds_byte(wc * 32 + fr, fq * 8);
#define PG8_SA(b, h) (((b) * 2 + (h)) * HTB)
#define PG8_SB(b, h) ((4 + (b) * 2 + (h)) * HTB)
#define PG8_STAGE(bufoff, gbase, voff) do { _Pragma("unroll") for (int _i = 0; _i < 2; ++_i) \
        __builtin_amdgcn_global_load_lds((const unsigned*)((const char*)(gbase) + (voff)[_i]), (PG8_LAS unsigned*)(lds + (bufoff) + ldsw + _i * 8192), 16, 0, 0); } while (0)
#define PG8_LDA(dst, b, h) do { _Pragma("unroll") for (int m = 0; m < 4; ++m) _Pragma("unroll") for (int k = 0; k < 2; ++k) dst[m][k] = *(const PG8_LAS bf16x8*)(lds + PG8_SA(b, h) + aoff + m * 2048 + k * 1024); } while (0)
#define PG8_LDB(dst, b, h) do { _Pragma("unroll") for (int n = 0; n < 2; ++n) _Pragma("unroll") for (int k = 0; k < 2; ++k) dst[n][k] = *(const PG8_LAS bf16x8*)(lds + PG8_SB(b, h) + boff + n * 2048 + k * 1024); } while (0)
#define PG8_MMA(ai, bj, At, Bt) do { __builtin_amdgcn_s_setprio(1); _Pragma("unroll") for (int m = 0; m < 4; ++m) _Pragma("unroll") for (int n = 0; n < 2; ++n) _Pragma("unroll") for (int k = 0; k < 2; ++k) \
        acc[ai][bj][m][n] = __builtin_amdgcn_mfma_f32_16x16x32_bf16(Bt[n][k], At[m][k], acc[ai][bj][m][n], 0, 0, 0); __builtin_amdgcn_s_setprio(0); } while (0)
#define PG8_WAIT_V(n) asm volatile("s_waitcnt vmcnt(" #n ")" ::: "memory")
#define PG8_WAIT_L(n) asm volatile("s_waitcnt lgkmcnt(" #n ")" ::: "memory")
#define PG8_BAR __builtin_amdgcn_s_barrier()
#define PG8_SCHED __builtin_amdgcn_sched_barrier(0)
    Unit cur, nxt; int ui = 0;
    if (!S.next(0, cur)) return;
    f32x4 acc[2][2][4][2];
#pragma unroll
    for (int a = 0; a < 2; ++a)
#pragma unroll
        for (int b = 0; b < 2; ++b)
#pragma unroll
            for (int m = 0; m < 4; ++m)
#pragma unroll
                for (int n = 0; n < 2; ++n) acc[a][b][m][n] = (f32x4){0.f, 0.f, 0.f, 0.f};
    bf16x8 At[4][2], B0[2][2], B1[2][2];
    const char* cA = (const char*)g.A + (size_t)cur.pm * tstepA; const char* cB = (const char*)g.Bt + (size_t)cur.pn * tstepB;
    PG8_STAGE(PG8_SB(0, 0), cB, voffB); PG8_STAGE(PG8_SB(0, 1), cB + hstepB, voffB); PG8_STAGE(PG8_SA(0, 0), cA, voffA); PG8_STAGE(PG8_SA(0, 1), cA + hstepA, voffA);
    if (wr == 1) PG8_BAR;
    PG8_WAIT_V(2); PG8_BAR;
    PG8_STAGE(PG8_SB(1, 0), cB + kstep, voffB); PG8_STAGE(PG8_SA(1, 0), cA + kstep, voffA); PG8_STAGE(PG8_SB(1, 1), cB + hstepB + kstep, voffB);
    PG8_WAIT_V(6); PG8_BAR;
    for (;;) {
        const bool has_next = S.next(ui + 1, nxt);
        const char* nA = has_next ? (const char*)g.A + (size_t)nxt.pm * tstepA : cA; const char* nB = has_next ? (const char*)g.Bt + (size_t)nxt.pn * tstepB : cB;
#pragma unroll 1
        for (int t = 0; t < nt; t += 2) {
            const bool last = (t == nt - 2);
            const char* a1 = cA + (size_t)(t + 1) * kstep;
            const char* a2 = last ? nA : cA + (size_t)(t + 2) * kstep; const char* b2 = last ? nB : cB + (size_t)(t + 2) * kstep;
            const char* a3 = a2 + kstep; const char* b3 = b2 + kstep;
            PG8_LDB(B0, 0, 0); PG8_LDB(B1, 0, 1); PG8_SCHED; PG8_LDA(At, 0, 0); PG8_STAGE(PG8_SA(1, 1), a1 + hstepA, voffA);
            PG8_WAIT_V(8); PG8_WAIT_L(0); PG8_BAR; PG8_MMA(0, 0, At, B0); PG8_MMA(0, 1, At, B1); PG8_BAR; PG8_SCHED;
            PG8_LDA(At, 0, 1); PG8_STAGE(PG8_SB(0, 0), b2, voffB); PG8_STAGE(PG8_SB(0, 1), b2 + hstepB, voffB); PG8_STAGE(PG8_SA(0, 0), a2, voffA);
            PG8_WAIT_V(8); PG8_WAIT_L(0); PG8_BAR; PG8_MMA(1, 0, At, B0); PG8_MMA(1, 1, At, B1); PG8_BAR; PG8_SCHED;
            PG8_LDB(B0, 1, 0); PG8_LDB(B1, 1, 1); PG8_SCHED; PG8_LDA(At, 1, 0); PG8_STAGE(PG8_SA(0, 1), a2 + hstepA, voffA);
            PG8_WAIT_V(8); PG8_WAIT_L(0); PG8_BAR; PG8_MMA(0, 0, At, B0); PG8_MMA(0, 1, At, B1); PG8_BAR; PG8_SCHED;
            PG8_LDA(At, 1, 1); PG8_STAGE(PG8_SB(1, 0), b3, voffB); PG8_STAGE(PG8_SB(1, 1), b3 + hstepB, voffB); PG8_STAGE(PG8_SA(1, 0), a3, voffA);
            PG8_WAIT_V(8); PG8_WAIT_L(0); PG8_BAR; PG8_MMA(1, 0, At, B0); PG8_MMA(1, 1, At, B1); PG8_BAR; PG8_SCHED;
        }
        if constexpr (ALIGN_EPI) { if (wr == 0) PG8_BAR; }
        E(acc, cur, wr, wc, fr, fq);
        if (!has_next) break;
#pragma unroll
        for (int a = 0; a < 2; ++a)
#pragma unroll
            for (int b = 0; b < 2; ++b)
#pragma unroll
                for (int m = 0; m < 4; ++m)
#pragma unroll
                    for (int n = 0; n < 2; ++n) acc[a][b][m][n] = (f32x4){0.f, 0.f, 0.f, 0.f};
        cur = nxt; cA = nA; cB = nB; ++ui;
        if constexpr (ALIGN_EPI) { if (wr == 1) PG8_BAR; }
    }
    PG8_WAIT_V(0);
    if constexpr (!ALIGN_EPI) { if (wr == 0) PG8_BAR; }
    PG8_BAR;
#undef PG8_SA
#undef PG8_SB
#undef PG8_STAGE
#undef PG8_LDA
#undef PG8_LDB
#undef PG8_MMA
#undef PG8_WAIT_V
#undef PG8_WAIT_L
#undef PG8_BAR
#undef PG8_SCHED
}

__device__ __forceinline__ u32x2 pack4(f32x4 v) { u32x2 w; w.x = cvt_pk_bf16(v[0], v[1]); w.y = cvt_pk_bf16(v[2], v[3]); return w; }

struct EpiWin {
    static constexpr bool PERM = false;
    bf16_t* P; bf16_t* Kb; float* ssq; float* sskv; const float* rope; const float* ss1; const float* bias1;
    __device__ __forceinline__ void operator()(const f32x4 (&acc0)[2][2][4][2], const Unit& u, int wr, int wc, int fr, int fq) const {
        const int row0 = u.pm * BM + wr * 64 + fr, colb = u.pn * BM + wc * 32 + 4 * fq;
        const int s = (u.pm < 128) ? (u.pm >> 5) : 4;
        f32x4 bv[2][2];
#pragma unroll
        for (int bj = 0; bj < 2; ++bj)
#pragma unroll
            for (int n = 0; n < 2; ++n) bv[bj][n] = *(const f32x4*)(bias1 + s * NP + colb + bj * HALF + n * 16);
        float rrv[8], ssv[8];
#pragma unroll
        for (int q = 0; q < 8; ++q) { rrv[q] = ss1[row0 + (q >> 2) * HALF + (q & 3) * 16]; ssv[q] = 0.f; }
#pragma unroll
        for (int ai = 0; ai < 2; ++ai)
#pragma unroll
            for (int m = 0; m < 4; ++m) {
                const int row = row0 + ai * HALF + m * 16;
                const float rr = 1.0f / sqrtf(rrv[ai * 4 + m] * (1.0f / DM) + EPS);
                f32x4 acc[2][2][4][2];
#pragma unroll
                for (int bj = 0; bj < 2; ++bj)
#pragma unroll
                    for (int n = 0; n < 2; ++n) acc[ai][bj][m][n] = acc0[ai][bj][m][n] * rr + bv[bj][n];
                bf16_t* rp = P + (size_t)row * NP + colb + ((fq & 1) ? 12 : 0);
#pragma unroll
                for (int bj = 0; bj < 2; ++bj) { const u32x2 wa = pack4(acc[ai][bj][m][0]), wb = pack4(acc[ai][bj][m][1]);
                    const auto r0 = __builtin_amdgcn_permlane16_swap(wa.x, wb.x, false, false); const auto r1 = __builtin_amdgcn_permlane16_swap(wa.y, wb.y, false, false);
                    u32x4 w; w.x = r0[0]; w.y = r1[0]; w.z = r0[1]; w.w = r1[1];
                    *(u32x4*)(rp + bj * HALF) = w; }
                if (u.pn == 0) {
                    float ss = 0.f;
#pragma unroll
                    for (int bj = 0; bj < 2; ++bj)
#pragma unroll
                        for (int n = 0; n < 2; ++n) { const f32x4 v = acc[ai][bj][m][n]; ss += (v[0] * v[0] + v[1] * v[1]) + (v[2] * v[2] + v[3] * v[3]); }
                    ssv[ai * 4 + m] = ss;
                } else if (u.pn == 1) {
                    float ss = 0.f;
#pragma unroll
                    for (int n = 0; n < 2; ++n) { const f32x4 v = acc[ai][0][m][n]; ss += (v[0] * v[0] + v[1] * v[1]) + (v[2] * v[2] + v[3] * v[3]); }
                    ssv[ai * 4 + m] = ss;
                    if (wc == 0) {
                        f32x4 x1 = acc[ai][1][m][0], x2 = acc[ai][1][m][1];
                        if (u.pm < 128) {
                            const int tok = row & (SEQ - 1), pos = (fq < 2) ? (tok >> 6) : (tok & 63);
                            const f32x4 t0 = *(const f32x4*)(rope + pos * 16 + 8 * (fq & 1)), t1 = *(const f32x4*)(rope + pos * 16 + 8 * (fq & 1) + 4);
                            const f32x4 cs = {t0[0], t0[2], t1[0], t1[2]}, sn = {t0[1], t0[3], t1[1], t1[3]};
                            const f32x4 o1 = x1 * cs - x2 * sn, o2 = x1 * sn + x2 * cs; x1 = o1; x2 = o2;
                        }
                        const u32x2 w1 = pack4(x1), w2 = pack4(x2);
#pragma unroll
                        for (int h = 0; h < 4; ++h) { bf16_t* kp = Kb + (size_t)row * 384 + h * 96 + 64 + 4 * fq; *(u32x2*)kp = w1; *(u32x2*)(kp + 16) = w2; }
                    }
                }
            }
        if (u.pn < 2) { float* sp = (u.pn == 0) ? ssq : sskv;
#pragma unroll
            for (int q = 0; q < 8; ++q) { float ss = ssv[q]; ss += __shfl_xor(ss, 16); ss += __shfl_xor(ss, 32); if (fq == 0) atomicAdd(sp + row0 + (q >> 2) * HALF + (q & 3) * 16, ss); } }
    }
};
struct EpiQ {
    static constexpr bool PERM = false;
    bf16_t* Q; const float* ssq; const float* rope;
    __device__ __forceinline__ void operator()(const f32x4 (&acc)[2][2][4][2], const Unit& u, int wr, int wc, int fr, int fq) const {
        const int row0 = u.pm * BM + wr * 64 + fr;
        float rrv[8];
#pragma unroll
        for (int q = 0; q < 8; ++q) rrv[q] = ssq[row0 + (q >> 2) * HALF + (q & 3) * 16];
#pragma unroll
        for (int ai = 0; ai < 2; ++ai)
#pragma unroll
            for (int m = 0; m < 4; ++m) {
                const int row = row0 + ai * HALF + m * 16;
                const float r = 1.0f / sqrtf(rrv[ai * 4 + m] * (1.0f / 256.0f) + EPS);
#pragma unroll
                for (int bj = 0; bj < 2; ++bj) {
                    const int blk = u.pn * 8 + bj * 4 + wc;
                    if (blk < 12) {
                        f32x4 x1 = acc[ai][bj][m][0] * r, x2 = acc[ai][bj][m][1] * r;
                        if ((blk % 3) == 2 && u.pm < 128) {
                            const int tok = row & (SEQ - 1), pos = (fq < 2) ? (tok >> 6) : (tok & 63);
                            const f32x4 t0 = *(const f32x4*)(rope + pos * 16 + 8 * (fq & 1)), t1 = *(const f32x4*)(rope + pos * 16 + 8 * (fq & 1) + 4);
                            const f32x4 cs = {t0[0], t0[2], t1[0], t1[2]}, sn = {t0[1], t0[3], t1[1], t1[3]};
                            const f32x4 o1 = x1 * cs - x2 * sn, o2 = x1 * sn + x2 * cs; x1 = o1; x2 = o2;
                        }
                        bf16_t* qp = Q + (size_t)row * 384 + blk * 32 + 4 * fq;
                        *(u32x2*)qp = pack4(x1); *(u32x2*)(qp + 16) = pack4(x2);
                    }
                }
            }
    }
};
struct EpiKV {
    static constexpr bool PERM = false;
    bf16_t* Kb; bf16_t* Vb; const float* sskv;
    __device__ __forceinline__ void operator()(const f32x4 (&acc)[2][2][4][2], const Unit& u, int wr, int wc, int fr, int fq) const {
        const int row0 = u.pm * BM + wr * 64 + fr;
        float rrv[8];
#pragma unroll
        for (int q = 0; q < 8; ++q) rrv[q] = sskv[row0 + (q >> 2) * HALF + (q & 3) * 16];
#pragma unroll
        for (int ai = 0; ai < 2; ++ai)
#pragma unroll
            for (int m = 0; m < 4; ++m) {
                const int row = row0 + ai * HALF + m * 16;
                const float r = 1.0f / sqrtf(rrv[ai * 4 + m] * (1.0f / 128.0f) + EPS);
#pragma unroll
                for (int bj = 0; bj < 2; ++bj) {
                    const int blk = u.pn * 8 + bj * 4 + wc, h = blk >> 2, w0 = (blk & 3) * 32 + 4 * fq;
                    bf16_t* dp = (w0 < 64) ? (Kb + (size_t)row * 384 + h * 96 + w0) : (Vb + (size_t)row * 256 + h * 64 + (w0 - 64));
                    *(u32x2*)dp = pack4(acc[ai][bj][m][0] * r); *(u32x2*)(dp + 16) = pack4(acc[ai][bj][m][1] * r);
                }
            }
    }
};
template <bool IN_H> struct EpiRes {
    static constexpr bool PERM = false;
    const float* res_lat; const float* res_ctx; bf16_t* xr; float* out_ctx; const float* gate;
    bf16_t* XS; float* ssn; const float* gn; const float* scn;
    __device__ __forceinline__ void operator()(const f32x4 (&acc)[2][2][4][2], const Unit& u, int wr, int wc, int fr, int fq) const {
        const bool lat = IN_H || (u.pm < 128);
        const int s = (u.pm < 128) ? (u.pm >> 5) : 4;
        const int lrow0 = ((u.pm < 128) ? u.pm * BM : (u.pm - 128) * BM) + wr * 64 + fr;
        const int grow0 = u.pm * BM + wr * 64 + fr;
        const int col0 = u.pn * BM + wc * 32 + 4 * fq;
        f32x4 gv[2][2], gs[2][2];
#pragma unroll
        for (int bj = 0; bj < 2; ++bj)
#pragma unroll
            for (int n = 0; n < 2; ++n) { gv[bj][n] = *(const f32x4*)(gate + s * MODW + col0 + bj * HALF + n * 16);
                if (XS) gs[bj][n] = *(const f32x4*)(gn + col0 + bj * HALF + n * 16) * (*(const f32x4*)(scn + s * MODW + col0 + bj * HALF + n * 16) + 1.0f);
                else gs[bj][n] = (f32x4){0.f, 0.f, 0.f, 0.f}; }
        float ssv[8];
        constexpr int GRP = IN_H ? 4 : 2;
#pragma unroll
        for (int pr = 0; pr < 8 / GRP; ++pr) {
            f32x4 pre[IN_H ? 1 : GRP][2][2]; u32x2 preh[IN_H ? GRP : 1][2][2];
#pragma unroll
            for (int mm = 0; mm < GRP; ++mm) { const int q = pr * GRP + mm; const size_t off = (size_t)(lrow0 + (q >> 2) * HALF + (q & 3) * 16) * DM + col0;
#pragma unroll
                for (int bj = 0; bj < 2; ++bj)
#pragma unroll
                    for (int n = 0; n < 2; ++n) {
                        if constexpr (IN_H) preh[mm][bj][n] = *(const u32x2*)(xr + off + bj * HALF + n * 16);
                        else pre[mm][bj][n] = *(const f32x4*)((lat ? res_lat : res_ctx) + off + bj * HALF + n * 16); } }
#pragma unroll
            for (int mm = 0; mm < GRP; ++mm) { const int q = pr * GRP + mm, ai = q >> 2, m = q & 3;
                const size_t off = (size_t)(lrow0 + ai * HALF + m * 16) * DM + col0;
                const size_t goff = (size_t)(grow0 + ai * HALF + m * 16) * DM + col0;
                float ss = 0.f;
                const int odd12 = (fq & 1) ? 12 : 0;
#pragma unroll
                for (int bj = 0; bj < 2; ++bj) { f32x4 ov[2];
#pragma unroll
                    for (int n = 0; n < 2; ++n) { f32x4 rv;
                        if constexpr (IN_H) { const u32x2 w = preh[mm][bj][n]; rv = (f32x4){__builtin_bit_cast(float, w.x << 16), __builtin_bit_cast(float, w.x & 0xffff0000u), __builtin_bit_cast(float, w.y << 16), __builtin_bit_cast(float, w.y & 0xffff0000u)}; }
                        else rv = pre[mm][bj][n];
                        ov[n] = rv + gv[bj][n] * acc[ai][bj][m][n];
                        if (!lat) *(f32x4*)(out_ctx + off + bj * HALF + n * 16) = ov[n];
                        if (XS) ss += (ov[n][0] * ov[n][0] + ov[n][1] * ov[n][1]) + (ov[n][2] * ov[n][2] + ov[n][3] * ov[n][3]); }
                    if (lat) { const u32x2 wa = pack4(ov[0]), wb = pack4(ov[1]);
                        const auto r0 = __builtin_amdgcn_permlane16_swap(wa.x, wb.x, false, false); const auto r1 = __builtin_amdgcn_permlane16_swap(wa.y, wb.y, false, false);
                        u32x4 w; w.x = r0[0]; w.y = r1[0]; w.z = r0[1]; w.w = r1[1];
                        *(u32x4*)(xr + off + odd12 + bj * HALF) = w; }
                    if (XS) { const u32x2 wa = pack4(ov[0] * gs[bj][0]), wb = pack4(ov[1] * gs[bj][1]);
                        const auto r0 = __builtin_amdgcn_permlane16_swap(wa.x, wb.x, false, false); const auto r1 = __builtin_amdgcn_permlane16_swap(wa.y, wb.y, false, false);
                        u32x4 w; w.x = r0[0]; w.y = r1[0]; w.z = r0[1]; w.w = r1[1];
                        *(u32x4*)(XS + goff + odd12 + bj * HALF) = w; } }
                ssv[q] = ss;
            }
            asm volatile("" ::: "memory");
        }
        if (XS) {
#pragma unroll
            for (int q = 0; q < 8; ++q) { float ss = ssv[q]; ss += __shfl_xor(ss, 16); ss += __shfl_xor(ss, 32); if (fq == 0) atomicAdd(ssn + grow0 + (q >> 2) * HALF + (q & 3) * 16, ss); } }
    }
};
struct EpiPart {
    static constexpr bool PERM = false;
    float* part;
    __device__ __forceinline__ void operator()(const f32x4 (&acc)[2][2][4][2], const Unit& u, int wr, int wc, int fr, int fq) const {
        const int lrow0 = u.pm * BM + wr * 64 + fr, col0 = u.pn * BM + wc * 32 + 4 * fq;
#pragma unroll
        for (int ai = 0; ai < 2; ++ai)
#pragma unroll
            for (int m = 0; m < 4; ++m) { float* op = part + (size_t)(lrow0 + ai * HALF + m * 16) * DM + col0;
#pragma unroll
                for (int bj = 0; bj < 2; ++bj)
#pragma unroll
                    for (int n = 0; n < 2; ++n) *(f32x4*)(op + bj * HALF + n * 16) = acc[ai][bj][m][n]; }
    }
};
struct EpiFF1 {
    static constexpr bool PERM = true;
    bf16_t* O; int ldc; const float* ss2; const float* bias2;
    __device__ __forceinline__ void operator()(const f32x4 (&acc)[2][2][4][2], const Unit& u, int wr, int wc, int fr, int fq) const {
        const int row0 = u.pm * BM + wr * 64 + fr, col0 = u.pn * BM + wc * 32 + 8 * fq;
        const int s = (u.pm < 128) ? (u.pm >> 5) : 4;
        f32x4 bv[2][2];
#pragma unroll
        for (int bj = 0; bj < 2; ++bj)
#pragma unroll
            for (int n = 0; n < 2; ++n) bv[bj][n] = *(const f32x4*)(bias2 + s * DFF + col0 + bj * HALF + 4 * n);
        float rrv[8];
#pragma unroll
        for (int q = 0; q < 8; ++q) rrv[q] = ss2[row0 + (q >> 2) * HALF + (q & 3) * 16];
#pragma unroll
        for (int ai = 0; ai < 2; ++ai)
#pragma unroll
            for (int m = 0; m < 4; ++m) { const int row = row0 + ai * HALF + m * 16; bf16_t* rowp = O + (size_t)row * ldc + col0;
                const float rr = 1.0f / sqrtf(rrv[ai * 4 + m] * (1.0f / DM) + EPS);
#pragma unroll
                for (int bj = 0; bj < 2; ++bj) { f32x4 v0 = acc[ai][bj][m][0] * rr + bv[bj][0], v1 = acc[ai][bj][m][1] * rr + bv[bj][1];
#pragma unroll
                    for (int j = 0; j < 4; ++j) { const float a = fmaxf(v0[j], 0.f), b = fmaxf(v1[j], 0.f); v0[j] = a * a; v1[j] = b * b; }
                    u32x4 w; w.x = cvt_pk_bf16(v0[0], v0[1]); w.y = cvt_pk_bf16(v0[2], v0[3]); w.z = cvt_pk_bf16(v1[0], v1[1]); w.w = cvt_pk_bf16(v1[2], v1[3]);
                    *(u32x4*)(rowp + bj * HALF) = w; } }
    }
};
}

namespace att {
using bf16x8 = __attribute__((ext_vector_type(8))) short;
using s16x4 = __attribute__((ext_vector_type(4))) short;
using f32x16 = __attribute__((ext_vector_type(16))) float;
using u32x4 = __attribute__((ext_vector_type(4))) unsigned;
typedef unsigned short bf16_t;
constexpr int NW = 8, QBLK = 32, KVBLK = 64;
constexpr float THR = 8.f;
constexpr size_t SHM_V = 16384, SHM_K = 16384, SHM_ATTN = 2 * SHM_V + 2 * SHM_K + NW * 64 * 4;
#define KSWZ(row, colB) ((row) * 256 + ((colB) ^ (((row) & 15) << 4)))
#define SBAR() __builtin_amdgcn_sched_barrier(0)
__device__ __forceinline__ int crow(int r, int hi) { return (r & 3) + 8 * (r >> 2) + 4 * hi; }
__device__ __forceinline__ unsigned cvtpk(float lo, float hi) { unsigned r; asm volatile("v_cvt_pk_bf16_f32 %0, %1, %2" : "=v"(r) : "v"(lo), "v"(hi)); return r; }
__device__ __forceinline__ bf16x8 ld8(const bf16_t* p) { return *reinterpret_cast<const bf16x8*>(p); }

template <int DQK> __device__ __forceinline__ void partialSM(f32x16& p0, f32x16& p1, float& m_reg, float& mn, float& alpha) {
  constexpr float SCALE = (DQK == 96) ? 0.10206207261596577f : 0.125f;
  constexpr float C = SCALE * 1.4426950408889634f;
  float pmax = p0[0];
#pragma unroll
  for (int r = 1; r < 16; ++r) pmax = fmaxf(pmax, p0[r]);
#pragma unroll
  for (int r = 0; r < 16; ++r) pmax = fmaxf(pmax, p1[r]);
  { auto rr = __builtin_amdgcn_permlane32_swap(__float_as_uint(pmax), __float_as_uint(pmax), false, false);
    pmax = fmaxf(__uint_as_float(rr[0]), __uint_as_float(rr[1])); }
  if (__builtin_expect(__all(pmax - m_reg <= THR / SCALE), 1)) { mn = m_reg; alpha = 1.f; }
  else { mn = fmaxf(m_reg, pmax); alpha = __builtin_amdgcn_exp2f((m_reg - mn) * C); m_reg = mn; }
  float mnC = -mn * C;
#pragma unroll
  for (int r = 0; r < 16; ++r) p0[r] = fmaf(p0[r], C, mnC);
#pragma unroll
  for (int r = 0; r < 16; ++r) p1[r] = fmaf(p1[r], C, mnC);
#pragma unroll
  for (int r = 0; r < 16; ++r) p0[r] = __builtin_amdgcn_exp2f(p0[r]);
}
__device__ __forceinline__ void finishSM(f32x16& p0, f32x16& p1, float alpha, float& l_reg, bf16x8& pa0, bf16x8& pa1, bf16x8& pa2, bf16x8& pa3) {
#pragma unroll
  for (int r = 0; r < 16; ++r) p1[r] = __builtin_amdgcn_exp2f(p1[r]);
  float ps = 0;
#pragma unroll
  for (int r = 0; r < 16; ++r) ps += p0[r];
#pragma unroll
  for (int r = 0; r < 16; ++r) ps += p1[r];
  { auto rr = __builtin_amdgcn_permlane32_swap(__float_as_uint(ps), __float_as_uint(ps), false, false);
    ps = __uint_as_float(rr[0]) + __uint_as_float(rr[1]); }
  l_reg = l_reg * alpha + ps;
#define PK4(P, BASE, OUT) do { unsigned a0 = cvtpk(P[BASE + 0], P[BASE + 1]), a1 = cvtpk(P[BASE + 2], P[BASE + 3]);   \
    unsigned b0 = cvtpk(P[BASE + 4], P[BASE + 5]), b1 = cvtpk(P[BASE + 6], P[BASE + 7]);                              \
    auto r0 = __builtin_amdgcn_permlane32_swap(a0, b0, false, false); auto r1 = __builtin_amdgcn_permlane32_swap(a1, b1, false, false); \
    u32x4 w = {r0[0], r1[0], r0[1], r1[1]}; OUT = *reinterpret_cast<bf16x8*>(&w); } while (0)
  PK4(p0, 0, pa0); PK4(p0, 8, pa1); PK4(p1, 0, pa2); PK4(p1, 8, pa3);
#undef PK4
}
template <int DQK> __device__ __forceinline__ void qkt(f32x16& p0, f32x16& p1, const char* Ks, const bf16x8* qr, int r32, int hi) {
  p0 = f32x16{}; p1 = f32x16{};
#pragma unroll
  for (int d0 = 0; d0 < DQK / 16; ++d0) { int cb = (d0 * 16 + hi * 8) * 2;
    bf16x8 b0 = *reinterpret_cast<const bf16x8*>(Ks + KSWZ(r32, cb));
    bf16x8 b1 = *reinterpret_cast<const bf16x8*>(Ks + KSWZ(32 + r32, cb));
    p0 = __builtin_amdgcn_mfma_f32_32x32x16_bf16(b0, qr[d0], p0, 0, 0, 0);
    p1 = __builtin_amdgcn_mfma_f32_32x32x16_bf16(b1, qr[d0], p1, 0, 0, 0); }
}
__device__ __forceinline__ int v_st(int k, int c) { const int kk = (k & ~0xC) | ((k & 4) << 1) | ((k & 8) >> 1); return ((kk >> 3) * 4 + (c >> 5)) * 512 + ((kk & 7) * 32 + (c & 31)) * 2; }
__device__ __forceinline__ int v_rd_base(int lane) { return ((lane & 3) << 3) | (((lane >> 2) & 3) << 6) | (((lane >> 4) & 1) << 5) | (((lane >> 5) & 1) << 8); }
constexpr int v_rd_off(int d0, int ks, int half) { return d0 * 512 + ks * 4096 + half * 2048; }
template <int OFF> __device__ __forceinline__ s16x4 tr_read(int vb) {
  s16x4 r; asm volatile("ds_read_b64_tr_b16 %0, %1 offset:%2" : "=&v"(r) : "v"(vb), "i"(OFF) : "memory"); return r;
}
#define PKLH(L, H) (bf16x8){L[0], L[1], L[2], L[3], H[0], H[1], H[2], H[3]}
template <int D0> __device__ __forceinline__ void pv_one(f32x16& od, int vb, bf16x8 pa0, bf16x8 pa1, bf16x8 pa2, bf16x8 pa3) {
  const s16x4 l0 = tr_read<v_rd_off(D0, 0, 0)>(vb), h0 = tr_read<v_rd_off(D0, 0, 1)>(vb), l1 = tr_read<v_rd_off(D0, 1, 0)>(vb), h1 = tr_read<v_rd_off(D0, 1, 1)>(vb);
  const s16x4 l2 = tr_read<v_rd_off(D0, 2, 0)>(vb), h2 = tr_read<v_rd_off(D0, 2, 1)>(vb), l3 = tr_read<v_rd_off(D0, 3, 0)>(vb), h3 = tr_read<v_rd_off(D0, 3, 1)>(vb);
  asm volatile("s_waitcnt lgkmcnt(0)" ::: "memory"); SBAR();
  od = __builtin_amdgcn_mfma_f32_32x32x16_bf16(pa0, PKLH(l0, h0), od, 0, 0, 0);
  od = __builtin_amdgcn_mfma_f32_32x32x16_bf16(pa1, PKLH(l1, h1), od, 0, 0, 0);
  od = __builtin_amdgcn_mfma_f32_32x32x16_bf16(pa2, PKLH(l2, h2), od, 0, 0, 0);
  od = __builtin_amdgcn_mfma_f32_32x32x16_bf16(pa3, PKLH(l3, h3), od, 0, 0, 0);
}
__device__ __forceinline__ void pv_d0(f32x16* o, int vb, bf16x8 pa0, bf16x8 pa1, bf16x8 pa2, bf16x8 pa3) {
  pv_one<0>(o[0], vb, pa0, pa1, pa2, pa3); pv_one<1>(o[1], vb, pa0, pa1, pa2, pa3);
}
struct NaInfo { const float* brow; int qr, qc; };
__device__ __forceinline__ void na_bias(f32x16& p0, f32x16& p1, const NaInfo& na, int kr, int hi) {
  const int rs = min(max(na.qr - 4, 0), 120);
  if (kr < rs || kr >= rs + 8) {
#pragma unroll
    for (int r = 0; r < 16; ++r) { p0[r] = -1e30f; p1[r] = -1e30f; }
  } else {
    const float* b = na.brow + (kr - na.qr + 7) * 31 + (15 - na.qc) + 4 * hi;
    const int ws = min(max(na.qc - 8, 0), 48) - 4 * hi;
#pragma unroll
    for (int r = 0; r < 16; ++r) {
      const int kc0 = (r & 3) + 8 * (r >> 2);
      const bool ok1 = (unsigned)(kc0 - ws) < 16u, ok2 = (unsigned)(kc0 + 32 - ws) < 16u;
      const float b1 = b[kc0], b2 = b[kc0 + 32];
      p0[r] = ok1 ? p0[r] + 8.0f * b1 : -1e30f;
      p1[r] = ok2 ? p1[r] + 8.0f * b2 : -1e30f;
      if ((r & 3) == 3) SBAR();
    }
  }
}

template <int DQK, int MODE, int ldq, int ldk, int ldv>
__device__ __forceinline__ void attn_unit(const bf16_t* __restrict__ Qb, const bf16_t* __restrict__ Kp, const bf16_t* __restrict__ Vp,
                                          int rowA, int nA, int rowB, int NT, bf16_t* __restrict__ Ob, char* lds, int rpb_off, int r0, int rs0) {
  constexpr int ldo = DM;
  const int tid = fresh_tid(), wid = tid >> 6, lane = tid & 63, r32 = lane & 31, hi = lane >> 5;
  char* V_lds = lds; char* K_lds = lds + 2 * SHM_V;
  float* ws = (float*)(lds + 2 * SHM_V + 2 * SHM_K) + wid * 64; float* li_l = ws; float* al_l = ws + 32;
  float m_reg = -1e30f, l_reg = 0; f32x16 o[2] = {}; bf16x8 qr[DQK / 16];
  const bf16_t* Qw = Qb + (long)(wid * QBLK + r32) * ldq + hi * 8;
#pragma unroll
  for (int d0 = 0; d0 < DQK / 16; ++d0) qr[d0] = ld8(Qw + d0 * 16);
  NaInfo na; na.brow = (const float*)(lds + rpb_off); na.qr = r0 + (wid >> 1); na.qc = (wid & 1) * 32 + r32;
  const int sr = tid >> 3, sc = (tid & 7) * 8, vst0 = v_st(sr, sc), kst0 = KSWZ(sr, sc * 2);
  const int sr2 = (tid & 255) >> 2, sc2 = 64 + (tid & 3) * 8, kst1 = KSWZ(sr2, sc2 * 2);
  const int vb0 = (int)(uintptr_t)V_lds + v_rd_base(lane);
  struct { bf16x8 vs0, ks0, ks1; } sr_[2];
#define KROW(j) (((j) < nA) ? (rowA + (j) * KVBLK) : (rowB + ((j) - nA) * KVBLK))
#define SLOAD(i, j) do { const long kr_ = KROW(j); sr_[i].vs0 = ld8(Vp + (kr_ + sr) * ldv + sc); sr_[i].ks0 = ld8(Kp + (kr_ + sr) * ldk + sc); \
    if (DQK == 96) sr_[i].ks1 = ld8(Kp + (kr_ + sr2) * ldk + sc2); } while (0)
#define SWRITE(b, i) do { *(bf16x8*)(V_lds + (b) * SHM_V + vst0) = sr_[i].vs0; *(bf16x8*)(K_lds + (b) * SHM_K + kst0) = sr_[i].ks0; \
    if (DQK == 96) *(bf16x8*)(K_lds + (b) * SHM_K + kst1) = sr_[i].ks1; } while (0)
#define RESC(a) do { if (__any((a) < 1.f)) { if (hi == 0) al_l[r32] = (a); asm volatile("s_waitcnt lgkmcnt(0)" ::: "memory"); \
    _Pragma("unroll") for (int d = 0; d < 2; ++d) _Pragma("unroll") for (int r = 0; r < 16; ++r) o[d][r] *= al_l[crow(r, hi)]; } } while (0)
#define BIAS(P0, P1, j) do { if (MODE == 1) { SBAR(); if ((j) >= nA) na_bias(P0, P1, na, rs0 + (j) - nA, hi); SBAR(); } } while (0)
  f32x16 pA0, pA1, pB0, pB1; float mnA, mnB, alA, alB; bf16x8 pa0, pa1, pa2, pa3;
  constexpr int SE = 0, SO = 1;
  SLOAD(SE, 0); SLOAD(SO, 1); asm volatile("s_waitcnt vmcnt(0)" ::: "memory"); SWRITE(0, SE); SWRITE(1, SO);
  if (2 < NT) SLOAD(SE, 2);
  __syncthreads();
  qkt<DQK>(pA0, pA1, K_lds, qr, r32, hi); BIAS(pA0, pA1, 0); partialSM<DQK>(pA0, pA1, m_reg, mnA, alA);
  for (int j = 1; j + 1 < NT; j += 2) {
    SBAR(); qkt<DQK>(pB0, pB1, K_lds + SHM_K, qr, r32, hi);
    finishSM(pA0, pA1, alA, l_reg, pa0, pa1, pa2, pa3); SBAR();
    SLOAD(SO, j + 2); SBAR();
    pv_d0(o, vb0, pa0, pa1, pa2, pa3); BIAS(pB0, pB1, j); partialSM<DQK>(pB0, pB1, m_reg, mnB, alB);
    __syncthreads(); SWRITE(0, SE);
    RESC(alB); __syncthreads();
    SBAR(); qkt<DQK>(pA0, pA1, K_lds, qr, r32, hi);
    finishSM(pB0, pB1, alB, l_reg, pa0, pa1, pa2, pa3); SBAR();
    if (j + 3 < NT) SLOAD(SE, j + 3); SBAR();
    pv_d0(o, vb0 + (int)SHM_V, pa0, pa1, pa2, pa3); BIAS(pA0, pA1, j + 1); partialSM<DQK>(pA0, pA1, m_reg, mnA, alA);
    __syncthreads(); SWRITE(1, SO);
    RESC(alA); __syncthreads();
  }
  SBAR(); qkt<DQK>(pB0, pB1, K_lds + SHM_K, qr, r32, hi);
  finishSM(pA0, pA1, alA, l_reg, pa0, pa1, pa2, pa3); SBAR();
  pv_d0(o, vb0, pa0, pa1, pa2, pa3); BIAS(pB0, pB1, NT - 1); partialSM<DQK>(pB0, pB1, m_reg, mnB, alB);
  __syncthreads(); RESC(alB);
  finishSM(pB0, pB1, alB, l_reg, pa0, pa1, pa2, pa3); SBAR();
  pv_d0(o, vb0 + (int)SHM_V, pa0, pa1, pa2, pa3);
  if (hi == 0) li_l[r32] = l_reg; asm volatile("s_waitcnt lgkmcnt(0)" ::: "memory");
  float rli[16];
#pragma unroll
  for (int r = 0; r < 16; ++r) rli[r] = __builtin_amdgcn_rcpf(li_l[crow(r, hi)]);
  bf16_t* Ow = Ob + (long)(wid * QBLK) * ldo;
#pragma unroll
  for (int r = 0; r < 16; ++r) { const int orow = crow(r, hi);
#pragma unroll
    for (int d0 = 0; d0 < 2; ++d0) { const unsigned w = cvtpk(o[d0][r] * rli[r], 0.f); Ow[(long)orow * ldo + d0 * 32 + r32] = (bf16_t)(w & 0xffffu); } }
  __syncthreads();
#undef KROW
#undef SLOAD
#undef SWRITE
#undef RESC
#undef BIAS
}
}

constexpr int NWAVES = 8, NTHR = 512;
constexpr int RING_BYTES = 131072;
constexpr int MISC_OFF = RING_BYTES;
constexpr int LDS_BYTES = 147456;
typedef unsigned short bf16;
typedef unsigned v4u __attribute__((ext_vector_type(4)));
typedef unsigned v2u __attribute__((ext_vector_type(2)));
typedef float f32x4 __attribute__((ext_vector_type(4)));

__device__ __forceinline__ unsigned f2bf(float f) { unsigned u = __builtin_bit_cast(unsigned, f); return (u + 0x7fffu + ((u >> 16) & 1u)) >> 16; }
__device__ __forceinline__ unsigned pk2(float lo, float hi) { return f2bf(lo) | (f2bf(hi) << 16); }
__device__ __forceinline__ float bf2f(unsigned short b) { return __builtin_bit_cast(float, (unsigned)b << 16); }
__device__ __forceinline__ float wave_sum(float v) {
#pragma unroll
    for (int o = 1; o < 64; o <<= 1) v += __shfl_xor(v, o);
    return v;
}
__device__ __forceinline__ float siluf(float x) { return x / (1.0f + __expf(-x)); }

struct Args { const float* in[22]; float* out; unsigned char* ws; int ph_lo, ph_hi; };

struct Ctx {
    char* lds; int tid, lane, wave, vcu, G, bx; unsigned argoff;
    unsigned char* ws;
};

constexpr int ARGS_OFF = MISC_OFF + 12288;
__device__ __forceinline__ const float* inptr(const Ctx& F, int i) {
    const __attribute__((address_space(3))) unsigned* p = (const __attribute__((address_space(3))) unsigned*)(uintptr_t)(F.argoff + 8u * (unsigned)i);
    const unsigned lo = __builtin_amdgcn_readfirstlane(p[0]), hi = __builtin_amdgcn_readfirstlane(p[1]);
    return (const float*)(const __attribute__((address_space(1))) float*)(((unsigned long long)hi << 32) | lo);
}
__device__ __forceinline__ void refresh(Ctx& F) { F.tid = fresh_tid(); F.lane = F.tid & 63; F.wave = __builtin_amdgcn_readfirstlane(F.tid >> 6); }
__device__ __forceinline__ void tr_item(const float* W, int ldw, int ncols, bf16* WT, int ldt, int row_off, float* scr, int item, int lane, const float* kscale) {
    const int nblk = ncols / 32, kb = item / nblk, nb = item % nblk, k0 = 64 * kb, n0 = 32 * nb;
#pragma unroll 8
    for (int i = 0; i < 32; ++i) { const int kk = 2 * i + (lane >> 5); float v = W[(size_t)(k0 + kk) * ldw + n0 + (lane & 31)]; if (kscale) v *= kscale[k0 + kk]; scr[kk * 33 + (lane & 31)] = v; }
    asm volatile("s_waitcnt lgkmcnt(0)" ::: "memory");
    const int c = lane & 7;
#pragma unroll
    for (int j = 0; j < 4; ++j) { const int n = (lane >> 3) + 8 * j; const float* s = scr + (8 * c) * 33 + n;
        v4u o; o.x = pk2(s[0 * 33], s[1 * 33]); o.y = pk2(s[2 * 33], s[3 * 33]); o.z = pk2(s[4 * 33], s[5 * 33]); o.w = pk2(s[6 * 33], s[7 * 33]);
        *(v4u*)(WT + (size_t)(row_off + n0 + n) * ldt + k0 + 8 * c) = o; }
    asm volatile("s_waitcnt lgkmcnt(0)" ::: "memory");
}
__device__ __forceinline__ void fz_item(const float* Win, bf16* WinT, const float* tab64, int item, int lane) {
    const int part = item & 1, mb = (item >> 1) & 7, g = (item >> 4) & 3, kb = item >> 6, k0 = 64 * kb;
    f32x4 wr[16];
    const float* rowp = Win + (size_t)(k0 + lane) * D_IN + 1184 + 64 * g;
#pragma unroll
    for (int i = 0; i < 16; ++i) wr[i] = *(const f32x4*)(rowp + 4 * i);
    const int sh = part ? 48 : 0;
    for (int mm = 0; mm < 8; ++mm) {
        const int m = mb * 8 + mm; float acc = 0.f;
#pragma unroll
        for (int c = 0; c < 64; ++c) { const int t = (m * c + sh) & 63; acc += wr[c >> 2][c & 3] * tab64[t]; }
        WinT[(size_t)((part ? PC_ZI : PC_ZR) + 64 * g + m) * DM + k0 + lane] = (bf16)f2bf(acc);
    }
}

__device__ __forceinline__ void phase_prologue(Ctx& F) {
    refresh(F);
    unsigned char* ws = F.ws;
    float* mod = (float*)(ws + WS_MOD);
    const int tid = F.tid, lane = F.lane, wave = F.wave;
    float* tab64 = (float*)(F.lds + MISC_OFF);
    if (tid < 64) tab64[tid] = __builtin_amdgcn_cosf((float)tid * (1.0f / 64.0f));
    if (F.bx < 192) {
        float* sl = (float*)F.lds; float* red = (float*)(F.lds + 32768);
        for (int i = tid; i < 5 * DM; i += NTHR) { const int s = i >> 10, k = i & 1023; sl[i] = siluf(s < 4 ? inptr(F, 1)[s * DM + k] : inptr(F, 3)[k]); }
        __syncthreads();
        for (int item = F.bx; item < 192; item += F.G) {
            const int l = item / 96, j0 = (item % 96) * 64, cl = tid & 63, ks = tid >> 6;
            const float* wm = inptr(F, 4) + ((size_t)l * DM + ks * 128) * MODW + j0 + cl;
            float a0 = 0, a1 = 0, a2 = 0, a3 = 0, a4 = 0;
            for (int k8 = 0; k8 < 128; k8 += 16) { float w[16];
#pragma unroll
                for (int q = 0; q < 16; ++q) w[q] = wm[(size_t)(k8 + q) * MODW];
#pragma unroll
                for (int q = 0; q < 16; ++q) { const int kk = ks * 128 + k8 + q;
                    a0 += sl[kk] * w[q]; a1 += sl[1024 + kk] * w[q]; a2 += sl[2048 + kk] * w[q]; a3 += sl[3072 + kk] * w[q]; a4 += sl[4096 + kk] * w[q]; } }
            red[(ks * 5 + 0) * 64 + cl] = a0; red[(ks * 5 + 1) * 64 + cl] = a1; red[(ks * 5 + 2) * 64 + cl] = a2; red[(ks * 5 + 3) * 64 + cl] = a3; red[(ks * 5 + 4) * 64 + cl] = a4;
            __syncthreads();
            if (tid < 320) { const int s = tid >> 6; float v = inptr(F, 5)[l * MODW + j0 + cl];
                for (int q = 0; q < 8; ++q) v += red[(q * 5 + s) * 64 + cl];
                mod[(size_t)(l * 5 + s) * MODW + j0 + cl] = v; }
            __syncthreads();
        }
    }
    __syncthreads();
    if (F.bx == F.G - 1) {
        float* rope = (float*)(ws + WS_ROPE);
        for (int i = tid; i < 1024; i += NTHR) { const int pos = i >> 3, f = i & 7; const float inv = exp2f(-(float)f * (13.287712379549449f / 8.0f));
            const float rev = (float)pos * inv * 0.15915494309189535f; rope[2 * i] = __builtin_amdgcn_cosf(rev); rope[2 * i + 1] = __builtin_amdgcn_sinf(rev); }
    }
    if (F.bx == 0) { unsigned* bw = (unsigned*)(ws + WS_BAR); for (int i = tid; i < 3456; i += NTHR) bw[i] = 0u; }
    const int gt = F.bx * NTHR + tid, GT = F.G * NTHR;
    { float* z = (float*)(ws + WS_STAT); for (int i = gt; i < 8 * MT; i += GT) z[i] = 0.f; }
    for (int l = 0; l < 2; ++l) {
        v4u zz = {0u, 0u, 0u, 0u};
        bf16* wi = (bf16*)(ws + WS_WIN) + (size_t)l * NP * DM + (size_t)2208 * DM;
        for (int i = gt; i < 96 * DM / 8; i += GT) *(v4u*)(wi + (size_t)i * 8) = zz;
        bf16* wq = (bf16*)(ws + WS_WUQ) + (size_t)l * 512 * 256 + (size_t)384 * 256;
        for (int i = gt; i < 128 * 256 / 8; i += GT) *(v4u*)(wq + (size_t)i * 8) = zz;
        bf16* wk = (bf16*)(ws + WS_WUKV) + (size_t)l * 512 * 256;
        for (int i = gt; i < 512 * 16; i += GT) *(v4u*)(wk + (size_t)(i >> 4) * 256 + 128 + (i & 15) * 8) = zz;
    }
    float* scr = (float*)(F.lds + wave * 16384);
    const int gw = F.vcu * NWAVES + wave, NGW = F.G * NWAVES;
    constexpr int I_A = 16 * 37, I_B = 16 * 16, I_Q = 4 * 12, I_KV = 2 * 16, I_O = 16 * 32, I_1 = 16 * 128, I_2 = 64 * 32, I_FZ = 1024;
    constexpr int I_L = I_A + I_B + I_Q + I_KV + I_O + I_1 + I_2 + I_FZ;
    for (int it = gw; it < 2 * I_L; it += NGW) {
        const int l = it / I_L; int r = it % I_L;
        const float* win = inptr(F, 8) + (size_t)l * DM * D_IN; bf16* winT = (bf16*)(ws + WS_WIN) + (size_t)l * NP * DM;
        if (r < I_A) { tr_item(win, D_IN, 1184, winT, DM, 0, scr, r, lane, nullptr); continue; } r -= I_A;
        if (r < I_B) { tr_item(win + 1440, D_IN, 512, winT, DM, PC_CV, scr, r, lane, nullptr); continue; } r -= I_B;
        if (r < I_Q) { tr_item(inptr(F, 10) + (size_t)l * 256 * 384, 384, 384, (bf16*)(ws + WS_WUQ) + (size_t)l * 512 * 256, 256, 0, scr, r, lane, inptr(F, 9) + l * 256); continue; } r -= I_Q;
        if (r < I_KV) { tr_item(inptr(F, 12) + (size_t)l * 128 * 512, 512, 512, (bf16*)(ws + WS_WUKV) + (size_t)l * 512 * 256, 256, 0, scr, r, lane, inptr(F, 11) + l * 128); continue; } r -= I_KV;
        if (r < I_O) { tr_item(inptr(F, 18) + (size_t)l * DM * DM, DM, DM, (bf16*)(ws + WS_WOUT) + (size_t)l * DM * DM, DM, 0, scr, r, lane, nullptr); continue; } r -= I_O;
        if (r < I_1) { tr_item(inptr(F, 19) + (size_t)l * DM * DFF, DFF, DFF, (bf16*)(ws + WS_W1) + (size_t)l * DM * DFF, DM, 0, scr, r, lane, nullptr); continue; } r -= I_1;
        if (r < I_2) { tr_item(inptr(F, 20) + (size_t)l * DFF * DM, DM, DM, (bf16*)(ws + WS_W2) + (size_t)l * DM * DFF, DFF, 0, scr, r, lane, nullptr); continue; } r -= I_2;
        fz_item(win, winT, tab64, r, lane);
    }
}

__device__ __forceinline__ void phase_xs(Ctx& F, const float* xlat, const float* xctx, const float* g, const float* modl, float* ss1, bf16* XS) {
    refresh(F);
    const int gw = F.vcu * NWAVES + F.wave, NGW = F.G * NWAVES, lane = F.lane;
    for (int row0 = 2 * gw; row0 < MT; row0 += 2 * NGW) {
        f32x4 v[2][4]; float ss[2] = {0.f, 0.f};
#pragma unroll
        for (int q = 0; q < 2; ++q) { const int row = row0 + q;
            const float* xr = row < ML ? xlat + (size_t)row * DM : xctx + (size_t)(row - ML) * DM;
#pragma unroll
            for (int j = 0; j < 4; ++j) v[q][j] = __builtin_nontemporal_load((const f32x4*)(xr + 256 * j + 4 * lane)); }
#pragma unroll
        for (int q = 0; q < 2; ++q) { const int row = row0 + q; const int s = row < ML ? (row >> 13) : 4;
            const float* sc = modl + s * MODW + DM;
#pragma unroll
            for (int j = 0; j < 4; ++j) ss[q] += (v[q][j][0] * v[q][j][0] + v[q][j][1] * v[q][j][1]) + (v[q][j][2] * v[q][j][2] + v[q][j][3] * v[q][j][3]);
            ss[q] = wave_sum(ss[q]);
            if (lane == 0) ss1[row] = ss[q];
#pragma unroll
            for (int j = 0; j < 4; ++j) { const int c = 256 * j + 4 * lane;
                const f32x4 gg = *(const f32x4*)(g + c), s1 = *(const f32x4*)(sc + c);
                const f32x4 y = v[q][j] * gg * (s1 + 1.0f);
                v2u w; w.x = pk2(y[0], y[1]); w.y = pk2(y[2], y[3]); *(v2u*)(XS + (size_t)row * DM + c) = w; } }
    }
}
constexpr int KSPLIT = 8;
__device__ __forceinline__ void phase_xs_ctx(Ctx& F, float* xctx, const float* part, const float* gate4, const float* g, const float* modl, float* ss1, bf16* XS) {
    refresh(F);
    const int gw = F.vcu * NWAVES + F.wave, NGW = F.G * NWAVES, lane = F.lane;
    for (int r = gw; r < MC; r += NGW) {
        const int row = ML + r;
        float* xr = xctx + (size_t)r * DM; const float* sc = modl + 4 * MODW + DM;
        f32x4 v[4]; float ss = 0.f;
#pragma unroll
        for (int j = 0; j < 4; ++j) { const int c = 256 * j + 4 * lane; f32x4 a = {0.f, 0.f, 0.f, 0.f};
#pragma unroll
            for (int ks = 0; ks < KSPLIT; ++ks) a += *(const f32x4*)(part + ((size_t)ks * MC + r) * DM + c);
            v[j] = *(const f32x4*)(xr + c) + *(const f32x4*)(gate4 + c) * a; *(f32x4*)(xr + c) = v[j];
            ss += (v[j][0] * v[j][0] + v[j][1] * v[j][1]) + (v[j][2] * v[j][2] + v[j][3] * v[j][3]); }
        ss = wave_sum(ss);
        if (lane == 0) ss1[row] = ss;
#pragma unroll
        for (int j = 0; j < 4; ++j) { const int c = 256 * j + 4 * lane;
            const f32x4 gg = *(const f32x4*)(g + c), s1 = *(const f32x4*)(sc + c);
            const f32x4 y = v[j] * gg * (s1 + 1.0f);
            v2u w; w.x = pk2(y[0], y[1]); w.y = pk2(y[2], y[3]); *(v2u*)(XS + (size_t)row * DM + c) = w; }
    }
}
__device__ __forceinline__ void phase_bias(Ctx& F) {
    refresh(F);
    unsigned char* ws = F.ws;
    const int gw = F.vcu * NWAVES + F.wave, NGW = F.G * NWAVES, lane = F.lane;
    for (int grp = 0; grp < 4; ++grp) {
        const int l = grp >> 1, which = grp & 1, nrows = which ? DFF : NP;
        const float* shb = (const float*)(ws + WS_MOD) + (size_t)l * 5 * MODW + (which ? 3 * DM : 0) + 16 * lane;
        const bf16* W = which ? (const bf16*)(ws + WS_W1) + (size_t)l * DM * DFF : (const bf16*)(ws + WS_WIN) + (size_t)l * NP * DM;
        float* outp = which ? (float*)(ws + WS_B2) + (size_t)l * 5 * DFF : (float*)(ws + WS_B1) + (size_t)l * 5 * NP;
        for (int n0 = gw; n0 < nrows; n0 += 2 * NGW) {
            const int n1 = n0 + NGW; const bool h1 = n1 < nrows; const int n1c = h1 ? n1 : n0;
            const v4u wa0 = *(const v4u*)(W + (size_t)n0 * DM + 16 * lane), wa1 = *(const v4u*)(W + (size_t)n0 * DM + 16 * lane + 8);
            const v4u wb0 = *(const v4u*)(W + (size_t)n1c * DM + 16 * lane), wb1 = *(const v4u*)(W + (size_t)n1c * DM + 16 * lane + 8);
            float fa[16], fb[16];
#pragma unroll
            for (int q = 0; q < 4; ++q) { fa[2 * q] = __builtin_bit_cast(float, wa0[q] << 16); fa[2 * q + 1] = __builtin_bit_cast(float, wa0[q] & 0xffff0000u);
                fa[8 + 2 * q] = __builtin_bit_cast(float, wa1[q] << 16); fa[8 + 2 * q + 1] = __builtin_bit_cast(float, wa1[q] & 0xffff0000u);
                fb[2 * q] = __builtin_bit_cast(float, wb0[q] << 16); fb[2 * q + 1] = __builtin_bit_cast(float, wb0[q] & 0xffff0000u);
                fb[8 + 2 * q] = __builtin_bit_cast(float, wb1[q] << 16); fb[8 + 2 * q + 1] = __builtin_bit_cast(float, wb1[q] & 0xffff0000u); }
#pragma unroll
            for (int sI = 0; sI < 5; ++sI) { float a = 0.f, b = 0.f;
#pragma unroll
                for (int q = 0; q < 4; ++q) { const f32x4 hv = *(const f32x4*)(shb + sI * MODW + 4 * q);
                    a += (hv[0] * fa[4 * q] + hv[1] * fa[4 * q + 1]) + (hv[2] * fa[4 * q + 2] + hv[3] * fa[4 * q + 3]);
                    b += (hv[0] * fb[4 * q] + hv[1] * fb[4 * q + 1]) + (hv[2] * fb[4 * q + 2] + hv[3] * fb[4 * q + 3]); }
                a = wave_sum(a); b = wave_sum(b);
                if (lane == 0) { outp[sI * nrows + n0] = a; if (h1) outp[sI * nrows + n1] = b; } }
        }
    }
}
__device__ __forceinline__ void phase_final(Ctx& F, const bf16* xr, float* out, const float* g) {
    refresh(F);
    const int gw = F.vcu * NWAVES + F.wave, NGW = F.G * NWAVES, lane = F.lane;
    f32x4 gg[4];
#pragma unroll
    for (int j = 0; j < 4; ++j) gg[j] = *(const f32x4*)(g + 256 * j + 4 * lane);
    for (int row0 = 4 * gw; row0 < ML; row0 += 4 * NGW) {
        v2u w[4][4];
#pragma unroll
        for (int q = 0; q < 4; ++q)
#pragma unroll
            for (int j = 0; j < 4; ++j) w[q][j] = *(const v2u*)(xr + (size_t)(row0 + q) * DM + 256 * j + 4 * lane);
#pragma unroll
        for (int q = 0; q < 4; ++q) { f32x4 v[4]; float ss = 0.f;
#pragma unroll
            for (int j = 0; j < 4; ++j) { v[j] = (f32x4){__builtin_bit_cast(float, w[q][j].x << 16), __builtin_bit_cast(float, w[q][j].x & 0xffff0000u), __builtin_bit_cast(float, w[q][j].y << 16), __builtin_bit_cast(float, w[q][j].y & 0xffff0000u)};
                ss += (v[j][0] * v[j][0] + v[j][1] * v[j][1]) + (v[j][2] * v[j][2] + v[j][3] * v[j][3]); }
            const float r = 1.0f / sqrtf(wave_sum(ss) * (1.0f / DM) + EPS);
#pragma unroll
            for (int j = 0; j < 4; ++j) __builtin_nontemporal_store(v[j] * r * gg[j], (f32x4*)(out + (size_t)(row0 + q) * DM + 256 * j + 4 * lane)); }
    }
}

__device__ __forceinline__ void conv_unit(Ctx& F, const bf16* P, bf16* O, int seq_row0, int seq_len, int t0, const float* wdw, const float* bdw, const float* lng, const float* lnb) {
    refresh(F);
    float* y = (float*)F.lds;
    const int tid = F.tid;
    {
        v4u av[6], gv[6]; bool okv[6];
#pragma unroll
        for (int q = 0; q < 6; ++q) { const int i = tid + q * NTHR, r = i >> 5, c8 = (i & 31) * 8, t = t0 - 15 + r;
            okv[q] = (i < 94 * 32) && t >= 0 && t < seq_len;
            const bf16* pr = P + (size_t)(seq_row0 + (okv[q] ? t : 0)) * NP + PC_CV + c8;
            av[q] = okv[q] ? *(const v4u*)pr : (v4u){0u, 0u, 0u, 0u}; gv[q] = okv[q] ? *(const v4u*)(pr + 256) : (v4u){0u, 0u, 0u, 0u}; }
#pragma unroll
        for (int q = 0; q < 6; ++q) { const int i = tid + q * NTHR, r = i >> 5, c8 = (i & 31) * 8;
            float o[8];
#pragma unroll
            for (int w = 0; w < 4; ++w) { const unsigned aw = av[q][w], gw = gv[q][w];
                const float a0 = __builtin_bit_cast(float, aw << 16), a1 = __builtin_bit_cast(float, aw & 0xffff0000u), g0 = __builtin_bit_cast(float, gw << 16), g1 = __builtin_bit_cast(float, gw & 0xffff0000u);
                o[2 * w] = okv[q] ? a0 / (1.0f + __expf(-g0)) : 0.f; o[2 * w + 1] = okv[q] ? a1 / (1.0f + __expf(-g1)) : 0.f; }
            if (i < 94 * 32) { *(f32x4*)(y + r * 256 + c8) = (f32x4){o[0], o[1], o[2], o[3]}; *(f32x4*)(y + r * 256 + c8 + 4) = (f32x4){o[4], o[5], o[6], o[7]}; } }
    }
    __syncthreads();
    const int c = tid & 255, hf = tid >> 8;
    float w[31];
#pragma unroll
    for (int k = 0; k < 31; ++k) w[k] = wdw[k * 256 + c];
    const float bb = bdw[c];
    float outv[32];
#pragma unroll
    for (int tt = 0; tt < 32; ++tt) { float a = bb; const float* yp = y + (hf * 32 + tt) * 256 + c;
#pragma unroll
        for (int k = 0; k < 31; ++k) a += w[k] * yp[k * 256];
        outv[tt] = a; }
    __syncthreads();
#pragma unroll
    for (int tt = 0; tt < 32; ++tt) y[(hf * 32 + tt) * 256 + c] = outv[tt];
    __syncthreads();
    const int lane = F.lane, wave = F.wave;
    const f32x4 gg = *(const f32x4*)(lng + 4 * lane), be = *(const f32x4*)(lnb + 4 * lane);
    for (int q = 0; q < 8; ++q) {
        const int tt = wave * 8 + q;
        const f32x4 v = *(const f32x4*)(y + tt * 256 + 4 * lane);
        const float mu = wave_sum((v[0] + v[1]) + (v[2] + v[3])) * (1.0f / 256.0f);
        const f32x4 d = v - mu;
        const float var = wave_sum((d[0] * d[0] + d[1] * d[1]) + (d[2] * d[2] + d[3] * d[3])) * (1.0f / 256.0f);
        const float rs = 1.0f / sqrtf(var + EPS);
        f32x4 o = d * rs * gg + be;
#pragma unroll
        for (int j = 0; j < 4; ++j) o[j] = siluf(o[j]);
        v2u wv; wv.x = pk2(o[0], o[1]); wv.y = pk2(o[2], o[3]);
        *(v2u*)(O + (size_t)(seq_row0 + t0 + tt) * DM + 768 + 4 * lane) = wv;
    }
    __syncthreads();
}

__device__ __forceinline__ void fourier_step1(Ctx& F, const bf16* P, bf16* Y) {
    refresh(F);
    using namespace att;
    const int tid = F.tid, lane = F.lane, wave = F.wave, r32 = lane & 31, hi = lane >> 5;
    bf16x8 afr[16];
    { const int k1 = 16 * wave + (r32 & 15); const bool isV = r32 >= 16;
#pragma unroll
      for (int s = 0; s < 16; ++s) {
        unsigned wv[4];
#pragma unroll
        for (int i2 = 0; i2 < 4; ++i2) { float e[2];
#pragma unroll
            for (int q = 0; q < 2; ++q) { const int kk = 16 * s + 8 * hi + 2 * i2 + q, part = kk >> 7, n1 = kk & 127; const int t = (k1 * n1) & 127;
                const float cs = __builtin_amdgcn_cosf((float)t * (1.0f / 128.0f)), sn = __builtin_amdgcn_sinf((float)t * (1.0f / 128.0f));
                e[q] = isV ? (part ? cs : sn) : (part ? -sn : cs); }
            wv[i2] = pk2(e[0], e[1]); }
        u32x4 w = {wv[0], wv[1], wv[2], wv[3]}; afr[s] = *reinterpret_cast<bf16x8*>(&w);
      } }
    char* img = F.lds;
    const int vb = (int)(uintptr_t)img + v_rd_base(lane);
    for (int prob = F.vcu; prob < 256; prob += F.G) {
        const int b = prob >> 6, n2 = prob & 63;
        for (int ch = 0; ch < 2; ++ch) {
#pragma unroll
            for (int q = 0; q < 8; ++q) { const int idx = q * NTHR + tid, kb = idx >> 10, k = (idx >> 4) & 63, c = (idx & 15) * 8;
                const int part = kb >> 1, n1 = (kb & 1) * 64 + k;
                const bf16x8 v = ld8(P + (size_t)(b * SEQ + 64 * n1 + n2) * NP + (part ? PC_ZI : PC_ZR) + 128 * ch + c);
                *(bf16x8*)(img + kb * 16384 + v_st(k, c)) = v; }
            __syncthreads();
#define F1_Q(Q, D0) do { \
                const s16x4 l0 = tr_read<(Q) * 16384 + v_rd_off(D0, 0, 0)>(vb), h0 = tr_read<(Q) * 16384 + v_rd_off(D0, 0, 1)>(vb), l1 = tr_read<(Q) * 16384 + v_rd_off(D0, 1, 0)>(vb), h1 = tr_read<(Q) * 16384 + v_rd_off(D0, 1, 1)>(vb); \
                const s16x4 l2 = tr_read<(Q) * 16384 + v_rd_off(D0, 2, 0)>(vb), h2 = tr_read<(Q) * 16384 + v_rd_off(D0, 2, 1)>(vb), l3 = tr_read<(Q) * 16384 + v_rd_off(D0, 3, 0)>(vb), h3 = tr_read<(Q) * 16384 + v_rd_off(D0, 3, 1)>(vb); \
                asm volatile("s_waitcnt lgkmcnt(0)" ::: "memory"); SBAR(); \
                acc = __builtin_amdgcn_mfma_f32_32x32x16_bf16(afr[4 * (Q) + 0], PKLH(l0, h0), acc, 0, 0, 0); acc = __builtin_amdgcn_mfma_f32_32x32x16_bf16(afr[4 * (Q) + 1], PKLH(l1, h1), acc, 0, 0, 0); \
                acc = __builtin_amdgcn_mfma_f32_32x32x16_bf16(afr[4 * (Q) + 2], PKLH(l2, h2), acc, 0, 0, 0); acc = __builtin_amdgcn_mfma_f32_32x32x16_bf16(afr[4 * (Q) + 3], PKLH(l3, h3), acc, 0, 0, 0); } while (0)
#define F1_D0(D0) do { f32x16 acc = {}; \
            F1_Q(0, D0); F1_Q(1, D0); F1_Q(2, D0); F1_Q(3, D0); \
            const int col = 128 * ch + 32 * (D0) + r32; \
            _Pragma("unroll") for (int r = 0; r < 8; ++r) { const int k1 = 16 * wave + crow(r, hi); const float rev = (float)(k1 * n2) * (1.0f / 8192.0f); \
                const float cb = __builtin_amdgcn_cosf(rev), sb = __builtin_amdgcn_sinf(rev); const float U = acc[r], V = acc[r + 8]; \
                bf16* yp = Y + ((size_t)((b * 128 + k1) * 2) * 64 + n2) * 256 + col; \
                yp[0] = (bf16)f2bf(U * cb - V * sb); yp[(size_t)64 * 256] = (bf16)f2bf(U * sb + V * cb); } } while (0)
            F1_D0(0); F1_D0(1); F1_D0(2); F1_D0(3);
#undef F1_D0
#undef F1_Q
            __syncthreads();
        }
    }
}
__device__ __forceinline__ void fourier_step2(Ctx& F, const bf16* Y, bf16* O) {
    refresh(F);
    using namespace att;
    const int tid = F.tid, lane = F.lane, wave = F.wave, r32 = lane & 31, hi = lane >> 5;
    bf16x8 afr[2][8];
#pragma unroll
    for (int mt = 0; mt < 2; ++mt)
#pragma unroll
      for (int s = 0; s < 8; ++s) { const int k2 = 32 * mt + r32;
        unsigned wv[4];
#pragma unroll
        for (int i2 = 0; i2 < 4; ++i2) { float e[2];
#pragma unroll
            for (int q = 0; q < 2; ++q) { const int kk = 16 * s + 8 * hi + 2 * i2 + q, part = kk >> 6, n2 = kk & 63; const int t = (k2 * n2) & 63;
                e[q] = part ? -__builtin_amdgcn_sinf((float)t * (1.0f / 64.0f)) : __builtin_amdgcn_cosf((float)t * (1.0f / 64.0f)); }
            wv[i2] = pk2(e[0], e[1]); }
        u32x4 w = {wv[0], wv[1], wv[2], wv[3]}; afr[mt][s] = *reinterpret_cast<bf16x8*>(&w); }
    char* img = F.lds;
    const int ch = wave >> 2, d0 = wave & 3;
    const int vb = (int)(uintptr_t)img + v_rd_base(lane) + ch * 32768 + d0 * 512;
    const float scale = 0.0013810679320049757f;
    for (int prob = F.vcu; prob < 512; prob += F.G) {
        const int b = prob >> 7, k1 = prob & 127;
        const bf16* src = Y + (size_t)((b * 128 + k1) * 2) * 64 * 256;
#pragma unroll
        for (int q = 0; q < 8; ++q) { const int idx = q * NTHR + tid, key = idx >> 5, c = (idx & 31) * 8;
            const bf16x8 v = ld8(src + (size_t)key * 256 + c);
            *(bf16x8*)(img + (c >> 7) * 32768 + (key >> 6) * 16384 + v_st(key & 63, c & 127)) = v; }
        __syncthreads();
        f32x16 acc0 = {}, acc1 = {};
#define F2_S(S, KB, KS) do { const s16x4 lo = tr_read<(KB) * 16384 + v_rd_off(0, KS, 0)>(vb), hh = tr_read<(KB) * 16384 + v_rd_off(0, KS, 1)>(vb); \
            asm volatile("s_waitcnt lgkmcnt(0)" ::: "memory"); SBAR(); const bf16x8 bb = PKLH(lo, hh); \
            acc0 = __builtin_amdgcn_mfma_f32_32x32x16_bf16(afr[0][S], bb, acc0, 0, 0, 0); acc1 = __builtin_amdgcn_mfma_f32_32x32x16_bf16(afr[1][S], bb, acc1, 0, 0, 0); } while (0)
        F2_S(0, 0, 0); F2_S(1, 0, 1); F2_S(2, 0, 2); F2_S(3, 0, 3); F2_S(4, 1, 0); F2_S(5, 1, 1); F2_S(6, 1, 2); F2_S(7, 1, 3);
#undef F2_S
        const int col = 512 + 32 * wave + r32;
#pragma unroll
        for (int r = 0; r < 16; ++r) { const int k2 = crow(r, hi);
            O[(size_t)(b * SEQ + k1 + 128 * k2) * DM + col] = (bf16)f2bf(acc0[r] * scale);
            O[(size_t)(b * SEQ + k1 + 128 * (k2 + 32)) * DM + col] = (bf16)f2bf(acc1[r] * scale); }
        __syncthreads();
    }
}
__device__ __forceinline__ void fourier_ctx(Ctx& F, const bf16* P, bf16* O) {
    refresh(F);
    float* tab = (float*)(F.lds + MISC_OFF + 512);
    const int tid = F.tid;
    if (tid < 256) tab[tid] = __builtin_amdgcn_cosf((float)tid * (1.0f / 256.0f));
    __syncthreads();
    const int col = tid & 255, kh = tid >> 8;
    for (int item = F.vcu; item < 256; item += F.G) {
        const int b = item >> 6, kq = (item & 63) * 4 + kh * 2;
        float a0 = 0.f, a1 = 0.f;
        const bf16* src = P + (size_t)(ML + b * CTXL) * NP;
        for (int n8 = 0; n8 < 256; n8 += 8) {
            unsigned short zr_[8], zi_[8];
#pragma unroll
            for (int q = 0; q < 8; ++q) { zr_[q] = src[(size_t)(n8 + q) * NP + PC_ZR + col]; zi_[q] = src[(size_t)(n8 + q) * NP + PC_ZI + col]; }
#pragma unroll
            for (int q = 0; q < 8; ++q) { const int n = n8 + q; const float zr = bf2f(zr_[q]), zi = bf2f(zi_[q]);
                const int i0 = (kq * n) & 255, i1 = ((kq + 1) * n) & 255;
                a0 += zr * tab[i0] - zi * tab[(i0 + 192) & 255];
                a1 += zr * tab[i1] - zi * tab[(i1 + 192) & 255]; }
        }
        O[(size_t)(ML + b * CTXL + kq) * DM + 512 + col] = (bf16)f2bf(a0 * (1.0f / 128.0f));
        O[(size_t)(ML + b * CTXL + kq + 1) * DM + 512 + col] = (bf16)f2bf(a1 * (1.0f / 128.0f));
    }
}

#define LAS __attribute__((address_space(3)))
#define XB_TMO      128
#define XB_XCNT(j)  (256  + 64 * (j))
#define XB_XSUB(j)  (1280 + 64 * (j))
#define XB_XGEN(j)  (2304 + 64 * (j))
#define XB_TOP      3328
#define XB_TOPGEN   3392
#define XCD_BAR_WORDS 3456
#define XB_SPIN_CAP (1u << 18)

__device__ __forceinline__ unsigned xb_ld(unsigned* p)              { return __hip_atomic_load(p, __ATOMIC_RELAXED, __HIP_MEMORY_SCOPE_AGENT); }
__device__ __forceinline__ unsigned xb_add(unsigned* p, unsigned v) { return __hip_atomic_fetch_add(p, v, __ATOMIC_RELAXED, __HIP_MEMORY_SCOPE_AGENT); }
__device__ __forceinline__ unsigned xb_xcc_id() { return (unsigned)__builtin_amdgcn_s_getreg((3 << 11) | 20) & 0xFu; }
#define XB_SPIN(cond, bar) do { unsigned _sp = 0; while (cond) { __builtin_amdgcn_s_sleep(1); \
    if ((++_sp & 255u) == 0u) { if (xb_ld(&(bar)[XB_TMO])) break; if (_sp > XB_SPIN_CAP) { atomicAdd(&(bar)[XB_TMO], 1u); break; } } } } while (0)

struct XcdBarrier {
    unsigned* bar; unsigned x;
    volatile LAS unsigned* st;
};

__device__ __forceinline__ XcdBarrier xcd_barrier_post(unsigned* bar, volatile LAS unsigned* st) {
    XcdBarrier b; b.bar = bar; b.x = xb_xcc_id(); b.st = st;
    if (threadIdx.x == 0) (void)xb_add(&bar[XB_XCNT(b.x)], 1u);
    return b;
}
__device__ __forceinline__ void xcd_barrier_complete(unsigned* bar, unsigned x, unsigned& nloc, unsigned& nx) {
    const unsigned G = gridDim.x * gridDim.y * gridDim.z;
    unsigned sum, cnt, mine, sp = 0u;
    for (;;) {
        sum = 0u; cnt = 0u; mine = 0u;
#pragma unroll
        for (unsigned j = 0; j < 16; ++j) { const unsigned c = xb_ld(&bar[XB_XCNT(j)]); sum += c; cnt += (c > 0u) ? 1u : 0u; mine = (j == x) ? c : mine; }
        if (sum == G) break;
        __builtin_amdgcn_s_sleep(1);
        if ((++sp & 255u) == 0u) { if (xb_ld(&bar[XB_TMO])) break; if (sp > XB_SPIN_CAP) { atomicAdd(&bar[XB_TMO], 1u); break; } }
    }
    nloc = mine > 0u ? mine : 1u; nx = cnt > 0u ? cnt : 1u;
}

__device__ __forceinline__ void xcd_barrier(const XcdBarrier& b) {
    asm volatile("s_waitcnt vmcnt(0)" ::: "memory");
    __syncthreads();
    if (threadIdx.x == 0) {
        unsigned* bar = b.bar;
        __builtin_amdgcn_s_waitcnt(0);
        unsigned nloc = b.st[0], nx = b.st[1];
        if (nloc == 0u) { xcd_barrier_complete(bar, b.x, nloc, nx); b.st[0] = nloc; b.st[1] = nx; }
        const unsigned old = xb_add(&bar[XB_XSUB(b.x)], 1u);
        const unsigned gen = old / nloc;
        if (old + 1u == (gen + 1u) * nloc) {
            __builtin_amdgcn_fence(__ATOMIC_RELEASE, "agent");
            asm volatile("s_waitcnt vmcnt(0)" ::: "memory");
            const unsigned og = xb_add(&bar[XB_TOP], 1u);
            const unsigned tg = og / nx;
            if (og + 1u == (tg + 1u) * nx) xb_add(&bar[XB_TOPGEN], 1u);
            else XB_SPIN(xb_ld(&bar[XB_TOPGEN]) == tg, bar);
            __builtin_amdgcn_fence(__ATOMIC_ACQUIRE, "agent");
            xb_add(&bar[XB_XGEN(b.x)], 1u);
            asm volatile("s_waitcnt vmcnt(0)" ::: "memory");
        } else {
            XB_SPIN(xb_ld(&bar[XB_XGEN(b.x)]) == gen, bar);
            __builtin_amdgcn_fence(__ATOMIC_ACQUIRE, "agent");
            asm volatile("s_waitcnt vmcnt(0)" ::: "memory");
        }
    }
    __syncthreads();
}


__device__ __forceinline__ void run_phase(Ctx& F0, const int p) {
    Ctx F = F0; F.argoff = (unsigned)(uintptr_t)F.lds + ARGS_OFF; asm volatile("" : "+s"(F.G), "+s"(F.vcu), "+s"(F.bx), "+s"(F.argoff));
    unsigned long long wsi_ = (unsigned long long)(uintptr_t)inptr(F, 23); asm volatile("" : "+s"(wsi_));
    unsigned char* ws = (unsigned char*)(__attribute__((address_space(1))) unsigned char*)wsi_;
    F.ws = ws;
    PG8_LAS unsigned char* ldsl = (PG8_LAS unsigned char*)(uintptr_t)(unsigned)(uintptr_t)F.lds;
    if (p == 0) {
#ifndef NO_PRO
        phase_prologue(F);
#endif
        return;
    }
    if (p == 1) {
        phase_xs(F, inptr(F, 0), inptr(F, 2), inptr(F, 6), (const float*)(ws + WS_MOD), STATP(ws, 0, 2), (bf16*)(ws + WS_XN));
        phase_bias(F);
        return;
    }
    if (p == 8) { phase_xs_ctx(F, (float*)(ws + WS_XC), (const float*)(ws + WS_Y), (const float*)(ws + WS_MOD) + (size_t)4 * MODW + 5 * DM, inptr(F, 6) + DM, (const float*)(ws + WS_MOD) + (size_t)5 * MODW, STATP(ws, 1, 2), (bf16*)(ws + WS_XN)); return; }
    if (p == 15) { phase_final(F, (const bf16*)(ws + WS_XR), (float*)inptr(F, 22), inptr(F, 21)); return; }
    const int l = (p >= 9) ? 1 : 0, sub = (p >= 9) ? (p - 8) : (p - 1);
    const bool last = (l == DEPTH - 1);
    const int Mrest = last ? ML : MT;
    if (sub == 1) {
        pg8::Gemm g{(const bf16*)(ws + WS_XN), (const bf16*)(ws + WS_WIN) + (size_t)l * NP * DM}; pg8::StaticOrder S; S.init(MT, NP, F.G, F.bx);
        pg8::EpiWin E{(bf16*)(ws + WS_P), (bf16*)(ws + WS_K), STATP(ws, l, 0), STATP(ws, l, 1), (const float*)(ws + WS_ROPE), STATP(ws, l, 2), (const float*)(ws + WS_B1) + (size_t)l * 5 * NP};
        pg8::gemm_phase<pg8::EpiWin, true, DM, DM, DM>(ldsl, g, S, E);
    } else if (sub == 2) {
        bf16* Pb = (bf16*)(ws + WS_P); bf16* Ob = (bf16*)(ws + WS_O);
#ifndef NO_GQ
        { pg8::Gemm g{Pb + PC_QA, (const bf16*)(ws + WS_WUQ) + (size_t)l * 512 * 256}; pg8::StaticOrder S; S.init(MT, 512, F.G, F.bx);
          pg8::EpiQ E{(bf16*)(ws + WS_Q), STATP(ws, l, 0), (const float*)(ws + WS_ROPE)}; pg8::gemm_phase<pg8::EpiQ, true, 256, NP, 256>(ldsl, g, S, E); }
#endif
#ifndef NO_GKV
        { pg8::Gemm g{Pb + PC_KVA, (const bf16*)(ws + WS_WUKV) + (size_t)l * 512 * 256}; pg8::StaticOrder S; S.init(MT, 512, F.G, F.G - 1 - F.bx);
          pg8::EpiKV E{(bf16*)(ws + WS_K), (bf16*)(ws + WS_V), STATP(ws, l, 1)}; pg8::gemm_phase<pg8::EpiKV, true, 256, NP, 256>(ldsl, g, S, E); }
#endif
        __syncthreads();
#ifndef NO_F1
        for (int rep_ = 0; rep_ < (PROBE_PART == 1 ? 2 : 1); ++rep_) {
        fourier_step1(F, Pb, (bf16*)(ws + WS_Y));
        if (!last) fourier_ctx(F, Pb, Ob);
        __syncthreads(); }
#endif
        __syncthreads();
#ifndef NO_CONV
        for (int rep_ = 0; rep_ < (PROBE_PART == 3 ? 2 : 1); ++rep_)
        { const int nun = last ? 512 : 528;
          const float* wdw = inptr(F, 14) + (size_t)l * 31 * 256; const float* bdw = inptr(F, 15) + l * 256; const float* lng = inptr(F, 16) + l * 256; const float* lnb = inptr(F, 17) + l * 256;
          for (int u = F.vcu; u < nun; u += F.G) {
              if (u < 512) conv_unit(F, Pb, Ob, (u >> 7) * SEQ, SEQ, (u & 127) * 64, wdw, bdw, lng, lnb);
              else { const int v = u - 512; conv_unit(F, Pb, Ob, ML + (v >> 2) * CTXL, CTXL, (v & 3) * 64, wdw, bdw, lng, lnb); }
          } }
#endif
#ifndef NO_NA
        for (int rep_ = 0; rep_ < (PROBE_PART == 2 ? 2 : 1); ++rep_)
        { float* rpb = (float*)(F.lds + MISC_OFF + 2048);
          for (int i = F.tid; i < 4 * 15 * 31; i += NTHR) rpb[i] = inptr(F, 13)[(size_t)l * 4 * 15 * 31 + i];
          __syncthreads();
          for (int u = F.vcu; u < 512; u += F.G) {
              const int bh = u >> 5, rb = u & 31, b = bh >> 2, h = bh & 3, r0 = 4 * rb, rs0 = min(max(r0 - 4, 0), 116);
              att::attn_unit<64, 1, NP, NP, NP>(Pb + (size_t)(b * SEQ + r0 * 64) * NP + PC_NAQ + h * 64, Pb + PC_NAK + h * 64, Pb + PC_NAV + h * 64,
                                    ML + b * CTXL, 4, b * SEQ + rs0 * 64, 16, Ob + (size_t)(b * SEQ + r0 * 64) * DM + 256 + h * 64, F.lds, MISC_OFF + 2048 + h * 15 * 31 * 4, r0, rs0);
          }
          if (!last) for (int u = F.vcu; u < 16; u += F.G) {
              const int b = u >> 2, h = u & 3;
              att::attn_unit<64, 1, NP, NP, NP>(Pb + (size_t)(ML + b * CTXL) * NP + PC_NAQ + h * 64, Pb + PC_NAK + h * 64, Pb + PC_NAV + h * 64,
                                    ML + b * CTXL, 4, 0, 4, Ob + (size_t)(ML + b * CTXL) * DM + 256 + h * 64, F.lds, MISC_OFF + 2048, 0, 0);
          } }
#endif
    } else if (sub == 3) {
        bf16* Qb = (bf16*)(ws + WS_Q); bf16* Kb = (bf16*)(ws + WS_K); bf16* Vb = (bf16*)(ws + WS_V); bf16* Ob = (bf16*)(ws + WS_O);
#ifndef NO_MLA
        for (int u = F.vcu; u < 512; u += F.G) {
            const int bh = u >> 5, qb = u & 31, b = bh >> 2, h = bh & 3;
            att::attn_unit<96, 0, 384, 384, 256>(Qb + (size_t)(b * SEQ + qb * 256) * 384 + h * 96, Kb + h * 96, Vb + h * 64,
                                  b * SEQ, 128, ML + b * CTXL, 132, Ob + (size_t)(b * SEQ + qb * 256) * DM + h * 64, F.lds, 0, 0, 0);
        }
        if (!last) for (int u = F.vcu; u < 16; u += F.G) {
            const int b = u >> 2, h = u & 3;
            att::attn_unit<96, 0, 384, 384, 256>(Qb + (size_t)(ML + b * CTXL) * 384 + h * 96, Kb + h * 96, Vb + h * 64,
                                  ML + b * CTXL, 4, 0, 4, Ob + (size_t)(ML + b * CTXL) * DM + h * 64, F.lds, 0, 0, 0);
        }
#endif
#ifndef NO_F2
        fourier_step2(F, (const bf16*)(ws + WS_Y), Ob);
#endif
    } else if (sub == 4) {
        pg8::Gemm g{(const bf16*)(ws + WS_O), (const bf16*)(ws + WS_WOUT) + (size_t)l * DM * DM}; pg8::StaticOrder S; S.init(Mrest, DM, F.G, F.bx);
        if (l == 0) {
            pg8::EpiRes<false> E{inptr(F, 0), inptr(F, 2), (bf16*)(ws + WS_XR), (float*)(ws + WS_XC), (const float*)(ws + WS_MOD) + (size_t)l * 5 * MODW + 2 * DM,
                                 (bf16*)(ws + WS_XN), STATP(ws, l, 3), inptr(F, 7) + l * DM, (const float*)(ws + WS_MOD) + (size_t)l * 5 * MODW + 4 * DM};
            pg8::gemm_phase<pg8::EpiRes<false>, true, DM, DM, DM>(ldsl, g, S, E);
        } else {
            pg8::EpiRes<true> E{nullptr, nullptr, (bf16*)(ws + WS_XR), nullptr, (const float*)(ws + WS_MOD) + (size_t)l * 5 * MODW + 2 * DM,
                                (bf16*)(ws + WS_XN), STATP(ws, l, 3), inptr(F, 7) + l * DM, (const float*)(ws + WS_MOD) + (size_t)l * 5 * MODW + 4 * DM};
            pg8::gemm_phase<pg8::EpiRes<true>, true, DM, DM, DM>(ldsl, g, S, E);
        }
    } else if (sub == 5) {
        pg8::Gemm g{(const bf16*)(ws + WS_XN), (const bf16*)(ws + WS_W1) + (size_t)l * DM * DFF}; pg8::StaticOrder S; S.init(Mrest, DFF, F.G, F.bx);
        pg8::EpiFF1 E{(bf16*)(ws + WS_H), DFF, STATP(ws, l, 3), (const float*)(ws + WS_B2) + (size_t)l * 5 * DFF};
        pg8::gemm_phase<pg8::EpiFF1, true, DM, DM, DM>(ldsl, g, S, E);
    } else {
        pg8::Gemm g{(const bf16*)(ws + WS_H), (const bf16*)(ws + WS_W2) + (size_t)l * DM * DFF}; pg8::StaticOrder S; S.init(ML, DM, F.G, F.bx);
        pg8::EpiRes<true> E{nullptr, nullptr, (bf16*)(ws + WS_XR), nullptr, (const float*)(ws + WS_MOD) + (size_t)l * 5 * MODW + 5 * DM,
                      last ? (bf16*)nullptr : (bf16*)(ws + WS_XN), STATP(ws, last ? l : l + 1, 2), inptr(F, 6) + (last ? l : l + 1) * DM, (const float*)(ws + WS_MOD) + (size_t)(last ? l : l + 1) * 5 * MODW + DM};
        pg8::gemm_phase<pg8::EpiRes<true>, true, DFF, DFF, DFF>(ldsl, g, S, E);
        if (!last) {
            for (int ks = 0; ks < KSPLIT; ++ks) {
                int c = F.bx - 16 * ks; if (c < 0) c += F.G;
                pg8::EpiPart EA{(float*)(ws + WS_Y) + (size_t)ks * MC * DM};
                pg8::Gemm gk{(const bf16*)(ws + WS_H) + (size_t)ML * DFF + ks * (DFF / KSPLIT), (const bf16*)(ws + WS_W2) + (size_t)l * DM * DFF + ks * (DFF / KSPLIT)}; pg8::StaticOrder Sk; Sk.init(MC, DM, F.G, c);
                pg8::gemm_phase<pg8::EpiPart, true, DFF / KSPLIT, DFF, DFF>(ldsl, gk, Sk, EA);
            }
        }
    }
}

__global__ void __launch_bounds__(NTHR, 2) mk_fwd(Args args) {
    extern __shared__ __attribute__((aligned(16))) unsigned char lds_raw[];
    cg::grid_group grid = cg::this_grid();
    Ctx F; F.lds = (char*)lds_raw; F.tid = threadIdx.x; F.lane = F.tid & 63; F.wave = __builtin_amdgcn_readfirstlane(F.tid >> 6);
    F.G = gridDim.x; F.bx = blockIdx.x; { const int bx = blockIdx.x; F.vcu = (F.G % 8 == 0) ? (bx % 8) * (F.G / 8) + bx / 8 : bx; }
    F.ws = nullptr;
    if (threadIdx.x == 0) {
        unsigned long long* la = (unsigned long long*)(F.lds + ARGS_OFF);
#pragma unroll
        for (int i = 0; i < 22; ++i) la[i] = (unsigned long long)args.in[i];
        la[22] = (unsigned long long)args.out; la[23] = (unsigned long long)args.ws;
    }
    __syncthreads();
    volatile LAS unsigned* bst = (volatile LAS unsigned*)(uintptr_t)((unsigned)(uintptr_t)F.lds + ARGS_OFF + 256);
    if (threadIdx.x < 2) bst[threadIdx.x] = 0u;
    __syncthreads();
    XcdBarrier bar; bar.bar = nullptr; bar.x = 0; bar.st = bst;
    for (int p = args.ph_lo; p < args.ph_hi; ++p) {
        run_phase(F, p);
        if (p + 1 < args.ph_hi) {
            if (p == args.ph_lo) { grid.sync(); bar = xcd_barrier_post((unsigned*)(args.ws + WS_BAR), bst); }
            else xcd_barrier(bar);
        }
    }
}
constexpr int N_PHASES = 16;

extern "C" void kernel_launch(void* const* d_in, const int* in_sizes, int n_in, void* d_out, int out_size, void* d_ws, size_t ws_size, hipStream_t stream) {
    static int grid = 0;
    if (grid == 0) {
        if (n_in != 22 || out_size != ML * DM || ws_size < WS_END) { fprintf(stderr, "kernel_launch: unexpected shapes n_in %d out %d ws %zu (need %zu)\n", n_in, out_size, ws_size, (size_t)WS_END); grid = -1; return; }
        int dev = 0, cus = 0, per_cu = 0;
        hipGetDevice(&dev); hipDeviceGetAttribute(&cus, hipDeviceAttributeMultiprocessorCount, dev);
        if (hipFuncSetAttribute((const void*)mk_fwd, hipFuncAttributeMaxDynamicSharedMemorySize, LDS_BYTES) != hipSuccess) { fprintf(stderr, "kernel_launch: hipFuncSetAttribute failed\n"); grid = -1; return; }
        hipOccupancyMaxActiveBlocksPerMultiprocessor(&per_cu, (const void*)mk_fwd, NTHR, LDS_BYTES);
        if (per_cu < 1) { fprintf(stderr, "kernel_launch: occupancy query says %d blocks per CU\n", per_cu); per_cu = 1; }
        (void)hipGetLastError();
        grid = cus;
    }
    if (grid < 0) return;
    Args a{};
    for (int i = 0; i < 22; ++i) a.in[i] = (const float*)d_in[i];
    a.out = (float*)d_out; a.ws = (unsigned char*)d_ws;
#if MK_MULTI
    for (int p = 0; p < N_PHASES; ++p) {
        a.ph_lo = p; a.ph_hi = p + 1;
        void* args[] = {&a};
        hipError_t e = hipLaunchCooperativeKernel((const void*)mk_fwd, dim3(grid), dim3(NTHR), args, LDS_BYTES, stream);
        if (e != hipSuccess) { fprintf(stderr, "launch %d failed: %s\n", p, hipGetErrorString(e)); break; }
    }
#else
    a.ph_lo = 0; a.ph_hi = N_PHASES;
    void* args[] = {&a};
    hipError_t e = hipLaunchCooperativeKernel((const void*)mk_fwd, dim3(grid), dim3(NTHR), args, LDS_BYTES, stream);
    if (e != hipSuccess) fprintf(stderr, "cooperative launch failed: %s (grid %d)\n", hipGetErrorString(e), grid);
#endif
}
```

```cpp
#include <hip/hip_runtime.h>
#include <hip/hip_cooperative_groups.h>
#include <hip/hip_bf16.h>
#include <cstdio>
#include <cstdint>
namespace cg = cooperative_groups;

#ifndef PROBE_PART
#define PROBE_PART 0
#endif
#ifndef MK_MULTI
#define MK_MULTI 0
#endif

constexpr int DM = 1024, NBATCH = 4, SEQ = 8192, CTXL = 256, DEPTH = 2, DFF = 4096;
constexpr int ML = NBATCH * SEQ, MC = NBATCH * CTXL, MT = ML + MC;
constexpr int D_IN = 1952;
constexpr int NP = 2304;
constexpr int PC_QA = 0, PC_KVA = 256, PC_KR = 384, PC_NAQ = 416, PC_NAK = 672, PC_NAV = 928, PC_ZR = 1184, PC_ZI = 1440, PC_CV = 1696;
constexpr float EPS = 1e-6f;
constexpr int MODW = 6 * DM;

constexpr size_t MiB = 1u << 20;
constexpr size_t WS_MOD = 0;
constexpr size_t WS_ROPE = 248 * 1024;
constexpr size_t WS_B1 = 256 * 1024;
constexpr size_t WS_B2 = 352 * 1024;
constexpr size_t WS_STAT = 512 * 1024;
#define STATP(ws, l, w) ((float*)((ws) + WS_STAT) + (size_t)((l) * 4 + (w)) * MT)
constexpr size_t WS_BAR = 1792 * 1024;
constexpr size_t WS_WIN = 2 * MiB;
constexpr size_t WS_WUQ = 11 * MiB;
constexpr size_t WS_WUKV = 11 * MiB + 512 * 1024;
constexpr size_t WS_WOUT = 12 * MiB;
constexpr size_t WS_W1 = 16 * MiB;
constexpr size_t WS_W2 = 32 * MiB;
constexpr size_t WS_XC = 48 * MiB;
constexpr size_t WS_XN = 52 * MiB;
constexpr size_t WS_Y = 118 * MiB;
constexpr size_t WS_H = 150 * MiB;
constexpr size_t WS_P = 150 * MiB;
constexpr size_t WS_Q = 299 * MiB;
constexpr size_t WS_K = 324 * MiB;
constexpr size_t WS_V = 349 * MiB;
constexpr size_t WS_O = 366 * MiB;
constexpr size_t WS_XR = 432 * MiB;
constexpr size_t WS_END = 496 * MiB;

__device__ __forceinline__ int fresh_tid() { int t = threadIdx.x; asm volatile("" : "+v"(t)); return t; }
namespace pg8 {
#define PG8_LAS __attribute__((address_space(3)))
typedef unsigned short bf16_t;
typedef short bf16x8 __attribute__((ext_vector_type(8)));
typedef float f32x4 __attribute__((ext_vector_type(4)));
typedef float f32x2 __attribute__((ext_vector_type(2)));
typedef unsigned u32x4 __attribute__((ext_vector_type(4)));
typedef unsigned u32x2 __attribute__((ext_vector_type(2)));
constexpr int BM = 256, BK = 64, HALF = 128, HTB = HALF * BK * 2, STAGE_BYTES = 8 * HTB, NXCD = 8, WGM = 8;

__host__ __device__ __forceinline__ int lds_byte(int r, int c) { const int st = (r >> 4) * 2 + (c >> 5), rr = r & 15, cc = c & 31, ob = rr * 64 + cc * 2; return st * 1024 + (ob ^ (((ob >> 9) & 1) << 5)); }
__host__ __device__ __forceinline__ void stage_rc(int b, int& R, int& C) { const int st = b / 1024, sb = b % 1024, swz = sb ^ (((sb >> 9) & 1) << 5); R = (st >> 1) * 16 + swz / 64; C = (st & 1) * 32 + (swz % 64) / 2; }
__host__ __device__ __forceinline__ int perm32(int rho) { const int n = rho >> 4, i = rho & 15; return 8 * (i >> 2) + 4 * n + (i & 3); }

struct Unit { int pm, pn; };
struct Gemm { const bf16_t* A; const bf16_t* Bt; };

struct StaticOrder {
    int nM, nN, nwg, G, c;
    __host__ __device__ void init(int M, int N, int G_, int c_) { nM = M / BM; nN = N / BM; nwg = nM * nN; G = G_; c = c_; }
    __host__ __device__ bool next(int i, Unit& u) const {
        const long L = (long)i * G + c; if (L >= nwg) return false;
        int wgid = (int)L; { const int q = nwg / NXCD, r = nwg % NXCD, xcd = wgid % NXCD, off = wgid / NXCD; wgid = (xcd < r ? xcd * (q + 1) : r * (q + 1) + (xcd - r) * q) + off; }
        const int nig = WGM * nN, gid = wgid / nig, fm = gid * WGM, gsz = (nM - fm) < WGM ? (nM - fm) : WGM;
        u.pm = fm + ((wgid % nig) % gsz); u.pn = (wgid % nig) / gsz; return true;
    }
};

__device__ __forceinline__ unsigned cvt_pk_bf16(float lo, float hi) { unsigned r; asm volatile("v_cvt_pk_bf16_f32 %0, %1, %2" : "=v"(r) : "v"(lo), "v"(hi)); return r; }

template <class Epi, bool ALIGN_EPI, int K, int LDA, int LDB>
__device__ __forceinline__ void gemm_phase(PG8_LAS unsigned char* lds, const Gemm g, const StaticOrder& S, const Epi& E) {
    const int tid = fresh_tid(), wid = __builtin_amdgcn_readfirstlane(tid >> 6), lane = tid & 63, wr = wid >> 2, wc = wid & 3, fr = lane & 15, fq = lane >> 4;
    constexpr int nt = K / BK;
    unsigned voffA[2], voffB[2];
#pragma unroll
    for (int i = 0; i < 2; ++i) { int R, C; stage_rc(tid * 16 + i * 8192, R, C); const int Rb = Epi::PERM ? ((R & ~31) + perm32(R & 31)) : R;
        voffA[i] = (unsigned)(R * LDA + C) * 2u; voffB[i] = (unsigned)(Rb * LDB + C) * 2u; }
    constexpr size_t kstep = (size_t)(BK * 2);
    constexpr size_t hstepA = (size_t)HALF * LDA * 2, hstepB = (size_t)HALF * LDB * 2;
    constexpr size_t tstepA = 2 * hstepA, tstepB = 2 * hstepB;
    const unsigned ldsw = (unsigned)wid * 1024u;
    const int aoff = lds_byte(wr * 64 + fr, fq * 8), boff = lds_byte(wc * 32 + fr, fq * 8);
#define PG8_SA(b, h) (((b) * 2 + (h)) * HTB)
#define PG8_SB(b, h) ((4 + (b) * 2 + (h)) * HTB)
#define PG8_STAGE(bufoff, gbase, voff) do { _Pragma("unroll") for (int _i = 0; _i < 2; ++_i) \
        __builtin_amdgcn_global_load_lds((const unsigned*)((const char*)(gbase) + (voff)[_i]), (PG8_LAS unsigned*)(lds + (bufoff) + ldsw + _i * 8192), 16, 0, 0); } while (0)
#define PG8_LDA(dst, b, h) do { _Pragma("unroll") for (int m = 0; m < 4; ++m) _Pragma("unroll") for (int k = 0; k < 2; ++k) dst[m][k] = *(const PG8_LAS bf16x8*)(lds + PG8_SA(b, h) + aoff + m * 2048 + k * 1024); } while (0)
#define PG8_LDB(dst, b, h) do { _Pragma("unroll") for (int n = 0; n < 2; ++n) _Pragma("unroll") for (int k = 0; k < 2; ++k) dst[n][k] = *(const PG8_LAS bf16x8*)(lds + PG8_SB(b, h) + boff + n * 2048 + k * 1024); } while (0)
#define PG8_MMA(ai, bj, At, Bt) do { __builtin_amdgcn_s_setprio(1); _Pragma("unroll") for (int m = 0; m < 4; ++m) _Pragma("unroll") for (int n = 0; n < 2; ++n) _Pragma("unroll") for (int k = 0; k < 2; ++k) \
        acc[ai][bj][m][n] = __builtin_amdgcn_mfma_f32_16x16x32_bf16(Bt[n][k], At[m][k], acc[ai][bj][m][n], 0, 0, 0); __builtin_amdgcn_s_setprio(0); } while (0)
#define PG8_WAIT_V(n) asm volatile("s_waitcnt vmcnt(" #n ")" ::: "memory")
#define PG8_WAIT_L(n) asm volatile("s_waitcnt lgkmcnt(" #n ")" ::: "memory")
#define PG8_BAR __builtin_amdgcn_s_barrier()
#define PG8_SCHED __builtin_amdgcn_sched_barrier(0)
    Unit cur, nxt; int ui = 0;
    if (!S.next(0, cur)) return;
    f32x4 acc[2][2][4][2];
#pragma unroll
    for (int a = 0; a < 2; ++a)
#pragma unroll
        for (int b = 0; b < 2; ++b)
#pragma unroll
            for (int m = 0; m < 4; ++m)
#pragma unroll
                for (int n = 0; n < 2; ++n) acc[a][b][m][n] = (f32x4){0.f, 0.f, 0.f, 0.f};
    bf16x8 At[4][2], B0[2][2], B1[2][2];
    const char* cA = (const char*)g.A + (size_t)cur.pm * tstepA; const char* cB = (const char*)g.Bt + (size_t)cur.pn * tstepB;
    PG8_STAGE(PG8_SB(0, 0), cB, voffB); PG8_STAGE(PG8_SB(0, 1), cB + hstepB, voffB); PG8_STAGE(PG8_SA(0, 0), cA, voffA); PG8_STAGE(PG8_SA(0, 1), cA + hstepA, voffA);
    if (wr == 1) PG8_BAR;
    PG8_WAIT_V(2); PG8_BAR;
    PG8_STAGE(PG8_SB(1, 0), cB + kstep, voffB); PG8_STAGE(PG8_SA(1, 0), cA + kstep, voffA); PG8_STAGE(PG8_SB(1, 1), cB + hstepB + kstep, voffB);
    PG8_WAIT_V(6); PG8_BAR;
    for (;;) {
        const bool has_next = S.next(ui + 1, nxt);
        const char* nA = has_next ? (const char*)g.A + (size_t)nxt.pm * tstepA : cA; const char* nB = has_next ? (const char*)g.Bt + (size_t)nxt.pn * tstepB : cB;
#pragma unroll 1
        for (int t = 0; t < nt; t += 2) {
            const bool last = (t == nt - 2);
            const char* a1 = cA + (size_t)(t + 1) * kstep;
            const char* a2 = last ? nA : cA + (size_t)(t + 2) * kstep; const char* b2 = last ? nB : cB + (size_t)(t + 2) * kstep;
            const char* a3 = a2 + kstep; const char* b3 = b2 + kstep;
            PG8_LDB(B0, 0, 0); PG8_LDB(B1, 0, 1); PG8_SCHED; PG8_LDA(At, 0, 0); PG8_STAGE(PG8_SA(1, 1), a1 + hstepA, voffA);
            PG8_WAIT_V(8); PG8_WAIT_L(0); PG8_BAR; PG8_MMA(0, 0, At, B0); PG8_MMA(0, 1, At, B1); PG8_BAR; PG8_SCHED;
            PG8_LDA(At, 0, 1); PG8_STAGE(PG8_SB(0, 0), b2, voffB); PG8_STAGE(PG8_SB(0, 1), b2 + hstepB, voffB); PG8_STAGE(PG8_SA(0, 0), a2, voffA);
            PG8_WAIT_V(8); PG8_WAIT_L(0); PG8_BAR; PG8_MMA(1, 0, At, B0); PG8_MMA(1, 1, At, B1); PG8_BAR; PG8_SCHED;
            PG8_LDB(B0, 1, 0); PG8_LDB(B1, 1, 1); PG8_SCHED; PG8_LDA(At, 1, 0); PG8_STAGE(PG8_SA(0, 1), a2 + hstepA, voffA);
            PG8_WAIT_V(8); PG8_WAIT_L(0); PG8_BAR; PG8_MMA(0, 0, At, B0); PG8_MMA(0, 1, At, B1); PG8_BAR; PG8_SCHED;
            PG8_LDA(At, 1, 1); PG8_STAGE(PG8_SB(1, 0), b3, voffB); PG8_STAGE(PG8_SB(1, 1), b3 + hstepB, voffB); PG8_STAGE(PG8_SA(1, 0), a3, voffA);
            PG8_WAIT_V(8); PG8_WAIT_L(0); PG8_BAR; PG8_MMA(1, 0, At, B0); PG8_MMA(1, 1, At, B1); PG8_BAR; PG8_SCHED;
        }
        if constexpr (ALIGN_EPI) { if (wr == 0) PG8_BAR; }
        E(acc, cur, wr, wc, fr, fq);
        if (!has_next) break;
#pragma unroll
        for (int a = 0; a < 2; ++a)
#pragma unroll
            for (int b = 0; b < 2; ++b)
#pragma unroll
                for (int m = 0; m < 4; ++m)
#pragma unroll
                    for (int n = 0; n < 2; ++n) acc[a][b][m][n] = (f32x4){0.f, 0.f, 0.f, 0.f};
        cur = nxt; cA = nA; cB = nB; ++ui;
        if constexpr (ALIGN_EPI) { if (wr == 1) PG8_BAR; }
    }
    PG8_WAIT_V(0);
    if constexpr (!ALIGN_EPI) { if (wr == 0) PG8_BAR; }
    PG8_BAR;
#undef PG8_SA
#undef PG8_SB
#undef PG8_STAGE
#undef PG8_LDA
#undef PG8_LDB
#undef PG8_MMA
#undef PG8_WAIT_V
#undef PG8_WAIT_L
#undef PG8_BAR
#undef PG8_SCHED
}

__device__ __forceinline__ u32x2 pack4(f32x4 v) { u32x2 w; w.x = cvt_pk_bf16(v[0], v[1]); w.y = cvt_pk_bf16(v[2], v[3]); return w; }

struct EpiWin {
    static constexpr bool PERM = false;
    bf16_t* P; bf16_t* Kb; float* ssq; float* sskv; const float* rope; const float* ss1; const float* bias1;
    __device__ __forceinline__ void operator()(const f32x4 (&acc0)[2][2][4][2], const Unit& u, int wr, int wc, int fr, int fq) const {
        const int row0 = u.pm * BM + wr * 64 + fr, colb = u.pn * BM + wc * 32 + 4 * fq;
        const int s = (u.pm < 128) ? (u.pm >> 5) : 4;
        f32x4 bv[2][2];
#pragma unroll
        for (int bj = 0; bj < 2; ++bj)
#pragma unroll
            for (int n = 0; n < 2; ++n) bv[bj][n] = *(const f32x4*)(bias1 + s * NP + colb + bj * HALF + n * 16);
        float rrv[8], ssv[8];
#pragma unroll
        for (int q = 0; q < 8; ++q) { rrv[q] = ss1[row0 + (q >> 2) * HALF + (q & 3) * 16]; ssv[q] = 0.f; }
#pragma unroll
        for (int ai = 0; ai < 2; ++ai)
#pragma unroll
            for (int m = 0; m < 4; ++m) {
                const int row = row0 + ai * HALF + m * 16;
                const float rr = 1.0f / sqrtf(rrv[ai * 4 + m] * (1.0f / DM) + EPS);
                f32x4 acc[2][2][4][2];
#pragma unroll
                for (int bj = 0; bj < 2; ++bj)
#pragma unroll
                    for (int n = 0; n < 2; ++n) acc[ai][bj][m][n] = acc0[ai][bj][m][n] * rr + bv[bj][n];
                bf16_t* rp = P + (size_t)row * NP + colb + ((fq & 1) ? 12 : 0);
#pragma unroll
                for (int bj = 0; bj < 2; ++bj) { const u32x2 wa = pack4(acc[ai][bj][m][0]), wb = pack4(acc[ai][bj][m][1]);
                    const auto r0 = __builtin_amdgcn_permlane16_swap(wa.x, wb.x, false, false); const auto r1 = __builtin_amdgcn_permlane16_swap(wa.y, wb.y, false, false);
                    u32x4 w; w.x = r0[0]; w.y = r1[0]; w.z = r0[1]; w.w = r1[1];
                    *(u32x4*)(rp + bj * HALF) = w; }
                if (u.pn == 0) {
                    float ss = 0.f;
#pragma unroll
                    for (int bj = 0; bj < 2; ++bj)
#pragma unroll
                        for (int n = 0; n < 2; ++n) { const f32x4 v = acc[ai][bj][m][n]; ss += (v[0] * v[0] + v[1] * v[1]) + (v[2] * v[2] + v[3] * v[3]); }
                    ssv[ai * 4 + m] = ss;
                } else if (u.pn == 1) {
                    float ss = 0.f;
#pragma unroll
                    for (int n = 0; n < 2; ++n) { const f32x4 v = acc[ai][0][m][n]; ss += (v[0] * v[0] + v[1] * v[1]) + (v[2] * v[2] + v[3] * v[3]); }
                    ssv[ai * 4 + m] = ss;
                    if (wc == 0) {
                        f32x4 x1 = acc[ai][1][m][0], x2 = acc[ai][1][m][1];
                        if (u.pm < 128) {
                            const int tok = row & (SEQ - 1), pos = (fq < 2) ? (tok >> 6) : (tok & 63);
                            const f32x4 t0 = *(const f32x4*)(rope + pos * 16 + 8 * (fq & 1)), t1 = *(const f32x4*)(rope + pos * 16 + 8 * (fq & 1) + 4);
                            const f32x4 cs = {t0[0], t0[2], t1[0], t1[2]}, sn = {t0[1], t0[3], t1[1], t1[3]};
                            const f32x4 o1 = x1 * cs - x2 * sn, o2 = x1 * sn + x2 * cs; x1 = o1; x2 = o2;
                        }
                        const u32x2 w1 = pack4(x1), w2 = pack4(x2);
#pragma unroll
                        for (int h = 0; h < 4; ++h) { bf16_t* kp = Kb + (size_t)row * 384 + h * 96 + 64 + 4 * fq; *(u32x2*)kp = w1; *(u32x2*)(kp + 16) = w2; }
                    }
                }
            }
        if (u.pn < 2) { float* sp = (u.pn == 0) ? ssq : sskv;
#pragma unroll
            for (int q = 0; q < 8; ++q) { float ss = ssv[q]; ss += __shfl_xor(ss, 16); ss += __shfl_xor(ss, 32); if (fq == 0) atomicAdd(sp + row0 + (q >> 2) * HALF + (q & 3) * 16, ss); } }
    }
};
struct EpiQ {
    static constexpr bool PERM = false;
    bf16_t* Q; const float* ssq; const float* rope;
    __device__ __forceinline__ void operator()(const f32x4 (&acc)[2][2][4][2], const Unit& u, int wr, int wc, int fr, int fq) const {
        const int row0 = u.pm * BM + wr * 64 + fr;
        float rrv[8];
#pragma unroll
        for (int q = 0; q < 8; ++q) rrv[q] = ssq[row0 + (q >> 2) * HALF + (q & 3) * 16];
#pragma unroll
        for (int ai = 0; ai < 2; ++ai)
#pragma unroll
            for (int m = 0; m < 4; ++m) {
                const int row = row0 + ai * HALF + m * 16;
                const float r = 1.0f / sqrtf(rrv[ai * 4 + m] * (1.0f / 256.0f) + EPS);
#pragma unroll
                for (int bj = 0; bj < 2; ++bj) {
                    const int blk = u.pn * 8 + bj * 4 + wc;
                    if (blk < 12) {
                        f32x4 x1 = acc[ai][bj][m][0] * r, x2 = acc[ai][bj][m][1] * r;
                        if ((blk % 3) == 2 && u.pm < 128) {
                            const int tok = row & (SEQ - 1), pos = (fq < 2) ? (tok >> 6) : (tok & 63);
                            const f32x4 t0 = *(const f32x4*)(rope + pos * 16 + 8 * (fq & 1)), t1 = *(const f32x4*)(rope + pos * 16 + 8 * (fq & 1) + 4);
                            const f32x4 cs = {t0[0], t0[2], t1[0], t1[2]}, sn = {t0[1], t0[3], t1[1], t1[3]};
                            const f32x4 o1 = x1 * cs - x2 * sn, o2 = x1 * sn + x2 * cs; x1 = o1; x2 = o2;
                        }
                        bf16_t* qp = Q + (size_t)row * 384 + blk * 32 + 4 * fq + ((fq & 1) ? 12 : 0);
                        { const u32x2 wa = pack4(x1), wb = pack4(x2);
                          const auto r0 = __builtin_amdgcn_permlane16_swap(wa.x, wb.x, false, false); const auto r1 = __builtin_amdgcn_permlane16_swap(wa.y, wb.y, false, false);
                          u32x4 w; w.x = r0[0]; w.y = r1[0]; w.z = r0[1]; w.w = r1[1]; *(u32x4*)qp = w; }
                    }
                }
            }
    }
};
struct EpiKV {
    static constexpr bool PERM = false;
    bf16_t* Kb; bf16_t* Vb; const float* sskv;
    __device__ __forceinline__ void operator()(const f32x4 (&acc)[2][2][4][2], const Unit& u, int wr, int wc, int fr, int fq) const {
        const int row0 = u.pm * BM + wr * 64 + fr;
        float rrv[8];
#pragma unroll
        for (int q = 0; q < 8; ++q) rrv[q] = sskv[row0 + (q >> 2) * HALF + (q & 3) * 16];
#pragma unroll
        for (int ai = 0; ai < 2; ++ai)
#pragma unroll
            for (int m = 0; m < 4; ++m) {
                const int row = row0 + ai * HALF + m * 16;
                const float r = 1.0f / sqrtf(rrv[ai * 4 + m] * (1.0f / 128.0f) + EPS);
#pragma unroll
                for (int bj = 0; bj < 2; ++bj) {
                    const int blk = u.pn * 8 + bj * 4 + wc, h = blk >> 2, w0 = (blk & 3) * 32 + 4 * fq;
                    bf16_t* dp = (w0 < 64) ? (Kb + (size_t)row * 384 + h * 96 + w0) : (Vb + (size_t)row * 256 + h * 64 + (w0 - 64));
                    { const u32x2 wa = pack4(acc[ai][bj][m][0] * r), wb = pack4(acc[ai][bj][m][1] * r);
                      const auto r0 = __builtin_amdgcn_permlane16_swap(wa.x, wb.x, false, false); const auto r1 = __builtin_amdgcn_permlane16_swap(wa.y, wb.y, false, false);
                      u32x4 w; w.x = r0[0]; w.y = r1[0]; w.z = r0[1]; w.w = r1[1]; *(u32x4*)(dp + ((fq & 1) ? 12 : 0)) = w; }
                }
            }
    }
};
template <bool IN_H> struct EpiRes {
    static constexpr bool PERM = false;
    const float* res_lat; const float* res_ctx; bf16_t* xr; float* out_ctx; const float* gate;
    bf16_t* XS; float* ssn; const float* gn; const float* scn;
    __device__ __forceinline__ void operator()(const f32x4 (&acc)[2][2][4][2], const Unit& u, int wr, int wc, int fr, int fq) const {
        const bool lat = IN_H || (u.pm < 128);
        const int s = (u.pm < 128) ? (u.pm >> 5) : 4;
        const int lrow0 = ((u.pm < 128) ? u.pm * BM : (u.pm - 128) * BM) + wr * 64 + fr;
        const int grow0 = u.pm * BM + wr * 64 + fr;
        const int col0 = u.pn * BM + wc * 32 + 4 * fq;
        f32x4 gv[2][2], gs[2][2];
#pragma unroll
        for (int bj = 0; bj < 2; ++bj)
#pragma unroll
            for (int n = 0; n < 2; ++n) { gv[bj][n] = *(const f32x4*)(gate + s * MODW + col0 + bj * HALF + n * 16);
                if (XS) gs[bj][n] = *(const f32x4*)(gn + col0 + bj * HALF + n * 16) * (*(const f32x4*)(scn + s * MODW + col0 + bj * HALF + n * 16) + 1.0f);
                else gs[bj][n] = (f32x4){0.f, 0.f, 0.f, 0.f}; }
        float ssv[8];
        constexpr int GRP = IN_H ? 4 : 2;
#pragma unroll
        for (int pr = 0; pr < 8 / GRP; ++pr) {
            f32x4 pre[IN_H ? 1 : GRP][2][2]; u32x4 prew[IN_H ? GRP : 1][2];
#pragma unroll
            for (int mm = 0; mm < GRP; ++mm) { const int q = pr * GRP + mm; const size_t off = (size_t)(lrow0 + (q >> 2) * HALF + (q & 3) * 16) * DM + col0;
#pragma unroll
                for (int bj = 0; bj < 2; ++bj)
                {   if constexpr (IN_H) prew[mm][bj] = *(const u32x4*)(xr + off + ((fq & 1) ? 12 : 0) + bj * HALF);
                    else {
#pragma unroll
                        for (int n = 0; n < 2; ++n) pre[mm][bj][n] = *(const f32x4*)((lat ? res_lat : res_ctx) + off + bj * HALF + n * 16); } } }
#pragma unroll
            for (int mm = 0; mm < GRP; ++mm) { const int q = pr * GRP + mm, ai = q >> 2, m = q & 3;
                const size_t off = (size_t)(lrow0 + ai * HALF + m * 16) * DM + col0;
                const size_t goff = (size_t)(grow0 + ai * HALF + m * 16) * DM + col0;
                float ss = 0.f;
                const int odd12 = (fq & 1) ? 12 : 0;
#pragma unroll
                for (int bj = 0; bj < 2; ++bj) { f32x4 ov[2]; u32x2 ph[2] = {};
                    if constexpr (IN_H) { const u32x4 w4 = prew[mm][bj];
                        const auto r0 = __builtin_amdgcn_permlane16_swap(w4.x, w4.z, false, false); const auto r1 = __builtin_amdgcn_permlane16_swap(w4.y, w4.w, false, false);
                        ph[0].x = r0[0]; ph[0].y = r1[0]; ph[1].x = r0[1]; ph[1].y = r1[1]; }
#pragma unroll
                    for (int n = 0; n < 2; ++n) { f32x4 rv;
                        if constexpr (IN_H) { const u32x2 w = ph[n]; rv = (f32x4){__builtin_bit_cast(float, w.x << 16), __builtin_bit_cast(float, w.x & 0xffff0000u), __builtin_bit_cast(float, w.y << 16), __builtin_bit_cast(float, w.y & 0xffff0000u)}; }
                        else rv = pre[mm][bj][n];
                        ov[n] = rv + gv[bj][n] * acc[ai][bj][m][n];
                        if (!lat) *(f32x4*)(out_ctx + off + bj * HALF + n * 16) = ov[n];
                        if (XS) ss += (ov[n][0] * ov[n][0] + ov[n][1] * ov[n][1]) + (ov[n][2] * ov[n][2] + ov[n][3] * ov[n][3]); }
                    if (lat) { const u32x2 wa = pack4(ov[0]), wb = pack4(ov[1]);
                        const auto r0 = __builtin_amdgcn_permlane16_swap(wa.x, wb.x, false, false); const auto r1 = __builtin_amdgcn_permlane16_swap(wa.y, wb.y, false, false);
                        u32x4 w; w.x = r0[0]; w.y = r1[0]; w.z = r0[1]; w.w = r1[1];
                        *(u32x4*)(xr + off + odd12 + bj * HALF) = w; }
                    if (XS) { const u32x2 wa = pack4(ov[0] * gs[bj][0]), wb = pack4(ov[1] * gs[bj][1]);
                        const auto r0 = __builtin_amdgcn_permlane16_swap(wa.x, wb.x, false, false); const auto r1 = __builtin_amdgcn_permlane16_swap(wa.y, wb.y, false, false);
                        u32x4 w; w.x = r0[0]; w.y = r1[0]; w.z = r0[1]; w.w = r1[1];
                        *(u32x4*)(XS + goff + odd12 + bj * HALF) = w; } }
                ssv[q] = ss;
            }
            asm volatile("" ::: "memory");
        }
        if (XS) {
#pragma unroll
            for (int q = 0; q < 8; ++q) { float ss = ssv[q]; ss += __shfl_xor(ss, 16); ss += __shfl_xor(ss, 32); if (fq == 0) atomicAdd(ssn + grow0 + (q >> 2) * HALF + (q & 3) * 16, ss); } }
    }
};
struct EpiPart {
    static constexpr bool PERM = false;
    float* part;
    __device__ __forceinline__ void operator()(const f32x4 (&acc)[2][2][4][2], const Unit& u, int wr, int wc, int fr, int fq) const {
        const int lrow0 = u.pm * BM + wr * 64 + fr, col0 = u.pn * BM + wc * 32 + 4 * fq;
#pragma unroll
        for (int ai = 0; ai < 2; ++ai)
#pragma unroll
            for (int m = 0; m < 4; ++m) { float* op = part + (size_t)(lrow0 + ai * HALF + m * 16) * DM + col0;
#pragma unroll
                for (int bj = 0; bj < 2; ++bj)
#pragma unroll
                    for (int n = 0; n < 2; ++n) *(f32x4*)(op + bj * HALF + n * 16) = acc[ai][bj][m][n]; }
    }
};
struct EpiFF1 {
    static constexpr bool PERM = true;
    bf16_t* O; int ldc; const float* ss2; const float* bias2;
    __device__ __forceinline__ void operator()(const f32x4 (&acc)[2][2][4][2], const Unit& u, int wr, int wc, int fr, int fq) const {
        const int row0 = u.pm * BM + wr * 64 + fr, col0 = u.pn * BM + wc * 32 + 8 * fq;
        const int s = (u.pm < 128) ? (u.pm >> 5) : 4;
        f32x4 bv[2][2];
#pragma unroll
        for (int bj = 0; bj < 2; ++bj)
#pragma unroll
            for (int n = 0; n < 2; ++n) bv[bj][n] = *(const f32x4*)(bias2 + s * DFF + col0 + bj * HALF + 4 * n);
        float rrv[8];
#pragma unroll
        for (int q = 0; q < 8; ++q) rrv[q] = ss2[row0 + (q >> 2) * HALF + (q & 3) * 16];
#pragma unroll
        for (int ai = 0; ai < 2; ++ai)
#pragma unroll
            for (int m = 0; m < 4; ++m) { const int row = row0 + ai * HALF + m * 16; bf16_t* rowp = O + (size_t)row * ldc + col0;
                const float rr = 1.0f / sqrtf(rrv[ai * 4 + m] * (1.0f / DM) + EPS);
#pragma unroll
                for (int bj = 0; bj < 2; ++bj) { f32x4 v0 = acc[ai][bj][m][0] * rr + bv[bj][0], v1 = acc[ai][bj][m][1] * rr + bv[bj][1];
#pragma unroll
                    for (int j = 0; j < 4; ++j) { const float a = fmaxf(v0[j], 0.f), b = fmaxf(v1[j], 0.f); v0[j] = a * a; v1[j] = b * b; }
                    u32x4 w; w.x = cvt_pk_bf16(v0[0], v0[1]); w.y = cvt_pk_bf16(v0[2], v0[3]); w.z = cvt_pk_bf16(v1[0], v1[1]); w.w = cvt_pk_bf16(v1[2], v1[3]);
                    *(u32x4*)(rowp + bj * HALF) = w; } }
    }
};
}

namespace att {
using bf16x8 = __attribute__((ext_vector_type(8))) short;
using s16x4 = __attribute__((ext_vector_type(4))) short;
using f32x16 = __attribute__((ext_vector_type(16))) float;
using u32x4 = __attribute__((ext_vector_type(4))) unsigned;
typedef unsigned short bf16_t;
constexpr int NW = 8, QBLK = 32, KVBLK = 64;
constexpr float THR = 8.f;
constexpr size_t SHM_V = 16384, SHM_K = 16384, SHM_ATTN = 2 * SHM_V + 2 * SHM_K + NW * 64 * 4;
#define KSWZ(row, colB) ((row) * 256 + ((colB) ^ (((row) & 15) << 4)))
#define SBAR() __builtin_amdgcn_sched_barrier(0)
__device__ __forceinline__ int crow(int r, int hi) { return (r & 3) + 8 * (r >> 2) + 4 * hi; }
__device__ __forceinline__ unsigned cvtpk(float lo, float hi) { unsigned r; asm volatile("v_cvt_pk_bf16_f32 %0, %1, %2" : "=v"(r) : "v"(lo), "v"(hi)); return r; }
__device__ __forceinline__ bf16x8 ld8(const bf16_t* p) { return *reinterpret_cast<const bf16x8*>(p); }

template <int DQK> __device__ __forceinline__ void partialSM(f32x16& p0, f32x16& p1, float& m_reg, float& mn, float& alpha) {
  constexpr float SCALE = (DQK == 96) ? 0.10206207261596577f : 0.125f;
  constexpr float C = SCALE * 1.4426950408889634f;
  float pmax = p0[0];
#pragma unroll
  for (int r = 1; r < 16; ++r) pmax = fmaxf(pmax, p0[r]);
#pragma unroll
  for (int r = 0; r < 16; ++r) pmax = fmaxf(pmax, p1[r]);
  { auto rr = __builtin_amdgcn_permlane32_swap(__float_as_uint(pmax), __float_as_uint(pmax), false, false);
    pmax = fmaxf(__uint_as_float(rr[0]), __uint_as_float(rr[1])); }
  if (__builtin_expect(__all(pmax - m_reg <= THR / SCALE), 1)) { mn = m_reg; alpha = 1.f; }
  else { mn = fmaxf(m_reg, pmax); alpha = __builtin_amdgcn_exp2f((m_reg - mn) * C); m_reg = mn; }
  float mnC = -mn * C;
#pragma unroll
  for (int r = 0; r < 16; ++r) p0[r] = fmaf(p0[r], C, mnC);
#pragma unroll
  for (int r = 0; r < 16; ++r) p1[r] = fmaf(p1[r], C, mnC);
#pragma unroll
  for (int r = 0; r < 16; ++r) p0[r] = __builtin_amdgcn_exp2f(p0[r]);
}
__device__ __forceinline__ void finishSM(f32x16& p0, f32x16& p1, float alpha, float& l_reg, bf16x8& pa0, bf16x8& pa1, bf16x8& pa2, bf16x8& pa3) {
#pragma unroll
  for (int r = 0; r < 16; ++r) p1[r] = __builtin_amdgcn_exp2f(p1[r]);
  float ps = 0;
#pragma unroll
  for (int r = 0; r < 16; ++r) ps += p0[r];
#pragma unroll
  for (int r = 0; r < 16; ++r) ps += p1[r];
  { auto rr = __builtin_amdgcn_permlane32_swap(__float_as_uint(ps), __float_as_uint(ps), false, false);
    ps = __uint_as_float(rr[0]) + __uint_as_float(rr[1]); }
  l_reg = l_reg * alpha + ps;
#define PK4(P, BASE, OUT) do { unsigned a0 = cvtpk(P[BASE + 0], P[BASE + 1]), a1 = cvtpk(P[BASE + 2], P[BASE + 3]);   \
    unsigned b0 = cvtpk(P[BASE + 4], P[BASE + 5]), b1 = cvtpk(P[BASE + 6], P[BASE + 7]);                              \
    auto r0 = __builtin_amdgcn_permlane32_swap(a0, b0, false, false); auto r1 = __builtin_amdgcn_permlane32_swap(a1, b1, false, false); \
    u32x4 w = {r0[0], r1[0], r0[1], r1[1]}; OUT = *reinterpret_cast<bf16x8*>(&w); } while (0)
  PK4(p0, 0, pa0); PK4(p0, 8, pa1); PK4(p1, 0, pa2); PK4(p1, 8, pa3);
#undef PK4
}
template <int DQK> __device__ __forceinline__ void qkt(f32x16& p0, f32x16& p1, const char* Ks, const bf16x8* qr, int r32, int hi) {
  p0 = f32x16{}; p1 = f32x16{};
#pragma unroll
  for (int d0 = 0; d0 < DQK / 16; ++d0) { int cb = (d0 * 16 + hi * 8) * 2;
    bf16x8 b0 = *reinterpret_cast<const bf16x8*>(Ks + KSWZ(r32, cb));
    bf16x8 b1 = *reinterpret_cast<const bf16x8*>(Ks + KSWZ(32 + r32, cb));
    p0 = __builtin_amdgcn_mfma_f32_32x32x16_bf16(b0, qr[d0], p0, 0, 0, 0);
    p1 = __builtin_amdgcn_mfma_f32_32x32x16_bf16(b1, qr[d0], p1, 0, 0, 0); }
}
__device__ __forceinline__ int v_st(int k, int c) { const int kk = (k & ~0xC) | ((k & 4) << 1) | ((k & 8) >> 1); return ((kk >> 3) * 4 + (c >> 5)) * 512 + ((kk & 7) * 32 + (c & 31)) * 2; }
__device__ __forceinline__ int v_rd_base(int lane) { return ((lane & 3) << 3) | (((lane >> 2) & 3) << 6) | (((lane >> 4) & 1) << 5) | (((lane >> 5) & 1) << 8); }
constexpr int v_rd_off(int d0, int ks, int half) { return d0 * 512 + ks * 4096 + half * 2048; }
template <int OFF> __device__ __forceinline__ s16x4 tr_read(int vb) {
  s16x4 r; asm volatile("ds_read_b64_tr_b16 %0, %1 offset:%2" : "=&v"(r) : "v"(vb), "i"(OFF) : "memory"); return r;
}
#define PKLH(L, H) (bf16x8){L[0], L[1], L[2], L[3], H[0], H[1], H[2], H[3]}
template <int D0> __device__ __forceinline__ void pv_one(f32x16& od, int vb, bf16x8 pa0, bf16x8 pa1, bf16x8 pa2, bf16x8 pa3) {
  const s16x4 l0 = tr_read<v_rd_off(D0, 0, 0)>(vb), h0 = tr_read<v_rd_off(D0, 0, 1)>(vb), l1 = tr_read<v_rd_off(D0, 1, 0)>(vb), h1 = tr_read<v_rd_off(D0, 1, 1)>(vb);
  const s16x4 l2 = tr_read<v_rd_off(D0, 2, 0)>(vb), h2 = tr_read<v_rd_off(D0, 2, 1)>(vb), l3 = tr_read<v_rd_off(D0, 3, 0)>(vb), h3 = tr_read<v_rd_off(D0, 3, 1)>(vb);
  asm volatile("s_waitcnt lgkmcnt(0)" ::: "memory"); SBAR();
  od = __builtin_amdgcn_mfma_f32_32x32x16_bf16(pa0, PKLH(l0, h0), od, 0, 0, 0);
  od = __builtin_amdgcn_mfma_f32_32x32x16_bf16(pa1, PKLH(l1, h1), od, 0, 0, 0);
  od = __builtin_amdgcn_mfma_f32_32x32x16_bf16(pa2, PKLH(l2, h2), od, 0, 0, 0);
  od = __builtin_amdgcn_mfma_f32_32x32x16_bf16(pa3, PKLH(l3, h3), od, 0, 0, 0);
}
__device__ __forceinline__ void pv_d0(f32x16* o, int vb, bf16x8 pa0, bf16x8 pa1, bf16x8 pa2, bf16x8 pa3) {
  pv_one<0>(o[0], vb, pa0, pa1, pa2, pa3); pv_one<1>(o[1], vb, pa0, pa1, pa2, pa3);
}
struct NaInfo { const float* brow; int qr, qc; };
__device__ __forceinline__ void na_bias(f32x16& p0, f32x16& p1, const NaInfo& na, int kr, int hi) {
  const int rs = min(max(na.qr - 4, 0), 120);
  if (kr < rs || kr >= rs + 8) {
#pragma unroll
    for (int r = 0; r < 16; ++r) { p0[r] = -1e30f; p1[r] = -1e30f; }
  } else {
    const float* b = na.brow + (kr - na.qr + 7) * 31 + (15 - na.qc) + 4 * hi;
    const int ws = min(max(na.qc - 8, 0), 48) - 4 * hi;
#pragma unroll
    for (int r = 0; r < 16; ++r) {
      const int kc0 = (r & 3) + 8 * (r >> 2);
      const bool ok1 = (unsigned)(kc0 - ws) < 16u, ok2 = (unsigned)(kc0 + 32 - ws) < 16u;
      const float b1 = b[kc0], b2 = b[kc0 + 32];
      p0[r] = ok1 ? p0[r] + 8.0f * b1 : -1e30f;
      p1[r] = ok2 ? p1[r] + 8.0f * b2 : -1e30f;
      if ((r & 3) == 3) SBAR();
    }
  }
}

template <int DQK, int MODE, int ldq, int ldk, int ldv>
__device__ __forceinline__ void attn_unit(const bf16_t* __restrict__ Qb, const bf16_t* __restrict__ Kp, const bf16_t* __restrict__ Vp,
                                          int rowA, int nA, int rowB, int NT, bf16_t* __restrict__ Ob, char* lds, int rpb_off, int r0, int rs0) {
  constexpr int ldo = DM;
  const int tid = fresh_tid(), wid = tid >> 6, lane = tid & 63, r32 = lane & 31, hi = lane >> 5;
  char* V_lds = lds; char* K_lds = lds + 2 * SHM_V;
  float* ws = (float*)(lds + 2 * SHM_V + 2 * SHM_K) + wid * 64; float* li_l = ws; float* al_l = ws + 32;
  float m_reg = -1e30f, l_reg = 0; f32x16 o[2] = {}; bf16x8 qr[DQK / 16];
  const bf16_t* Qw = Qb + (long)(wid * QBLK + r32) * ldq + hi * 8;
#pragma unroll
  for (int d0 = 0; d0 < DQK / 16; ++d0) qr[d0] = ld8(Qw + d0 * 16);
  NaInfo na; na.brow = (const float*)(lds + rpb_off); na.qr = r0 + (wid >> 1); na.qc = (wid & 1) * 32 + r32;
  const int sr = tid >> 3, sc = (tid & 7) * 8, vst0 = v_st(sr, sc), kst0 = KSWZ(sr, sc * 2);
  const int sr2 = (tid & 255) >> 2, sc2 = 64 + (tid & 3) * 8, kst1 = KSWZ(sr2, sc2 * 2);
  const int vb0 = (int)(uintptr_t)V_lds + v_rd_base(lane);
  struct { bf16x8 vs0, ks0, ks1; } sr_[2];
#define KROW(j) (((j) < nA) ? (rowA + (j) * KVBLK) : (rowB + ((j) - nA) * KVBLK))
#define SLOAD(i, j) do { const long kr_ = KROW(j); sr_[i].vs0 = ld8(Vp + (kr_ + sr) * ldv + sc); sr_[i].ks0 = ld8(Kp + (kr_ + sr) * ldk + sc); \
    if (DQK == 96) sr_[i].ks1 = ld8(Kp + (kr_ + sr2) * ldk + sc2); } while (0)
#define SWRITE(b, i) do { *(bf16x8*)(V_lds + (b) * SHM_V + vst0) = sr_[i].vs0; *(bf16x8*)(K_lds + (b) * SHM_K + kst0) = sr_[i].ks0; \
    if (DQK == 96) *(bf16x8*)(K_lds + (b) * SHM_K + kst1) = sr_[i].ks1; } while (0)
#define RESC(a) do { if (__any((a) < 1.f)) { if (hi == 0) al_l[r32] = (a); asm volatile("s_waitcnt lgkmcnt(0)" ::: "memory"); \
    _Pragma("unroll") for (int d = 0; d < 2; ++d) _Pragma("unroll") for (int r = 0; r < 16; ++r) o[d][r] *= al_l[crow(r, hi)]; } } while (0)
#define BIAS(P0, P1, j) do { if (MODE == 1) { SBAR(); if ((j) >= nA) na_bias(P0, P1, na, rs0 + (j) - nA, hi); SBAR(); } } while (0)
  f32x16 pA0, pA1, pB0, pB1; float mnA, mnB, alA, alB; bf16x8 pa0, pa1, pa2, pa3;
  constexpr int SE = 0, SO = 1;
  SLOAD(SE, 0); SLOAD(SO, 1); asm volatile("s_waitcnt vmcnt(0)" ::: "memory"); SWRITE(0, SE); SWRITE(1, SO);
  if (2 < NT) SLOAD(SE, 2);
  __syncthreads();
  qkt<DQK>(pA0, pA1, K_lds, qr, r32, hi); BIAS(pA0, pA1, 0); partialSM<DQK>(pA0, pA1, m_reg, mnA, alA);
  for (int j = 1; j + 1 < NT; j += 2) {
    SBAR(); qkt<DQK>(pB0, pB1, K_lds + SHM_K, qr, r32, hi);
    finishSM(pA0, pA1, alA, l_reg, pa0, pa1, pa2, pa3); SBAR();
    SLOAD(SO, j + 2); SBAR();
    pv_d0(o, vb0, pa0, pa1, pa2, pa3); BIAS(pB0, pB1, j); partialSM<DQK>(pB0, pB1, m_reg, mnB, alB);
    __syncthreads(); SWRITE(0, SE);
    RESC(alB); __syncthreads();
    SBAR(); qkt<DQK>(pA0, pA1, K_lds, qr, r32, hi);
    finishSM(pB0, pB1, alB, l_reg, pa0, pa1, pa2, pa3); SBAR();
    if (j + 3 < NT) SLOAD(SE, j + 3); SBAR();
    pv_d0(o, vb0 + (int)SHM_V, pa0, pa1, pa2, pa3); BIAS(pA0, pA1, j + 1); partialSM<DQK>(pA0, pA1, m_reg, mnA, alA);
    __syncthreads(); SWRITE(1, SO);
    RESC(alA); __syncthreads();
  }
  SBAR(); qkt<DQK>(pB0, pB1, K_lds + SHM_K, qr, r32, hi);
  finishSM(pA0, pA1, alA, l_reg, pa0, pa1, pa2, pa3); SBAR();
  pv_d0(o, vb0, pa0, pa1, pa2, pa3); BIAS(pB0, pB1, NT - 1); partialSM<DQK>(pB0, pB1, m_reg, mnB, alB);
  __syncthreads(); RESC(alB);
  finishSM(pB0, pB1, alB, l_reg, pa0, pa1, pa2, pa3); SBAR();
  pv_d0(o, vb0 + (int)SHM_V, pa0, pa1, pa2, pa3);
  if (hi == 0) li_l[r32] = l_reg; asm volatile("s_waitcnt lgkmcnt(0)" ::: "memory");
  float rli[16];
#pragma unroll
  for (int r = 0; r < 16; ++r) rli[r] = __builtin_amdgcn_rcpf(li_l[crow(r, hi)]);
  bf16_t* Ow = Ob + (long)(wid * QBLK) * ldo;
#pragma unroll
  for (int r = 0; r < 16; ++r) { const int orow = crow(r, hi);
#pragma unroll
    for (int d0 = 0; d0 < 2; ++d0) { const unsigned w = cvtpk(o[d0][r] * rli[r], 0.f); Ow[(long)orow * ldo + d0 * 32 + r32] = (bf16_t)(w & 0xffffu); } }
  __syncthreads();
#undef KROW
#undef SLOAD
#undef SWRITE
#undef RESC
#undef BIAS
}
}

constexpr int NWAVES = 8, NTHR = 512;
constexpr int RING_BYTES = 131072;
constexpr int MISC_OFF = RING_BYTES;
constexpr int LDS_BYTES = 147456;
typedef unsigned short bf16;
typedef unsigned v4u __attribute__((ext_vector_type(4)));
typedef unsigned v2u __attribute__((ext_vector_type(2)));
typedef float f32x4 __attribute__((ext_vector_type(4)));

__device__ __forceinline__ unsigned f2bf(float f) { unsigned u = __builtin_bit_cast(unsigned, f); return (u + 0x7fffu + ((u >> 16) & 1u)) >> 16; }
__device__ __forceinline__ unsigned pk2(float lo, float hi) { return f2bf(lo) | (f2bf(hi) << 16); }
__device__ __forceinline__ float bf2f(unsigned short b) { return __builtin_bit_cast(float, (unsigned)b << 16); }
__device__ __forceinline__ float wave_sum(float v) {
#pragma unroll
    for (int o = 1; o < 64; o <<= 1) v += __shfl_xor(v, o);
    return v;
}
__device__ __forceinline__ float siluf(float x) { return x / (1.0f + __expf(-x)); }

struct Args { const float* in[22]; float* out; unsigned char* ws; int ph_lo, ph_hi; };

struct Ctx {
    char* lds; int tid, lane, wave, vcu, G, bx; unsigned argoff;
    unsigned char* ws;
};

constexpr int ARGS_OFF = MISC_OFF + 12288;
__device__ __forceinline__ const float* inptr(const Ctx& F, int i) {
    const __attribute__((address_space(3))) unsigned* p = (const __attribute__((address_space(3))) unsigned*)(uintptr_t)(F.argoff + 8u * (unsigned)i);
    const unsigned lo = __builtin_amdgcn_readfirstlane(p[0]), hi = __builtin_amdgcn_readfirstlane(p[1]);
    return (const float*)(const __attribute__((address_space(1))) float*)(((unsigned long long)hi << 32) | lo);
}
__device__ __forceinline__ void refresh(Ctx& F) { F.tid = fresh_tid(); F.lane = F.tid & 63; F.wave = __builtin_amdgcn_readfirstlane(F.tid >> 6); }
__device__ __forceinline__ void tr_item(const float* W, int ldw, int ncols, bf16* WT, int ldt, int row_off, float* scr, int item, int lane, const float* kscale) {
    const int nblk = ncols / 32, kb = item / nblk, nb = item % nblk, k0 = 64 * kb, n0 = 32 * nb;
#pragma unroll 8
    for (int i = 0; i < 32; ++i) { const int kk = 2 * i + (lane >> 5); float v = W[(size_t)(k0 + kk) * ldw + n0 + (lane & 31)]; if (kscale) v *= kscale[k0 + kk]; scr[kk * 33 + (lane & 31)] = v; }
    asm volatile("s_waitcnt lgkmcnt(0)" ::: "memory");
    const int c = lane & 7;
#pragma unroll
    for (int j = 0; j < 4; ++j) { const int n = (lane >> 3) + 8 * j; const float* s = scr + (8 * c) * 33 + n;
        v4u o; o.x = pk2(s[0 * 33], s[1 * 33]); o.y = pk2(s[2 * 33], s[3 * 33]); o.z = pk2(s[4 * 33], s[5 * 33]); o.w = pk2(s[6 * 33], s[7 * 33]);
        *(v4u*)(WT + (size_t)(row_off + n0 + n) * ldt + k0 + 8 * c) = o; }
    asm volatile("s_waitcnt lgkmcnt(0)" ::: "memory");
}
__device__ __forceinline__ void fz_item(const float* Win, bf16* WinT, const float* tab64, int item, int lane) {
    const int part = item & 1, mb = (item >> 1) & 7, g = (item >> 4) & 3, kb = item >> 6, k0 = 64 * kb;
    f32x4 wr[16];
    const float* rowp = Win + (size_t)(k0 + lane) * D_IN + 1184 + 64 * g;
#pragma unroll
    for (int i = 0; i < 16; ++i) wr[i] = *(const f32x4*)(rowp + 4 * i);
    const int sh = part ? 48 : 0;
    for (int mm = 0; mm < 8; ++mm) {
        const int m = mb * 8 + mm; float acc = 0.f;
#pragma unroll
        for (int c = 0; c < 64; ++c) { const int t = (m * c + sh) & 63; acc += wr[c >> 2][c & 3] * tab64[t]; }
        WinT[(size_t)((part ? PC_ZI : PC_ZR) + 64 * g + m) * DM + k0 + lane] = (bf16)f2bf(acc);
    }
}

__device__ __forceinline__ void phase_prologue(Ctx& F) {
    refresh(F);
    unsigned char* ws = F.ws;
    float* mod = (float*)(ws + WS_MOD);
    const int tid = F.tid, lane = F.lane, wave = F.wave;
    float* tab64 = (float*)(F.lds + MISC_OFF);
    if (tid < 64) tab64[tid] = __builtin_amdgcn_cosf((float)tid * (1.0f / 64.0f));
    if (F.bx < 192) {
        float* sl = (float*)F.lds; float* red = (float*)(F.lds + 32768);
        for (int i = tid; i < 5 * DM; i += NTHR) { const int s = i >> 10, k = i & 1023; sl[i] = siluf(s < 4 ? inptr(F, 1)[s * DM + k] : inptr(F, 3)[k]); }
        __syncthreads();
        for (int item = F.bx; item < 192; item += F.G) {
            const int l = item / 96, j0 = (item % 96) * 64, cl = tid & 63, ks = tid >> 6;
            const float* wm = inptr(F, 4) + ((size_t)l * DM + ks * 128) * MODW + j0 + cl;
            float a0 = 0, a1 = 0, a2 = 0, a3 = 0, a4 = 0;
            for (int k8 = 0; k8 < 128; k8 += 16) { float w[16];
#pragma unroll
                for (int q = 0; q < 16; ++q) w[q] = wm[(size_t)(k8 + q) * MODW];
#pragma unroll
                for (int q = 0; q < 16; ++q) { const int kk = ks * 128 + k8 + q;
                    a0 += sl[kk] * w[q]; a1 += sl[1024 + kk] * w[q]; a2 += sl[2048 + kk] * w[q]; a3 += sl[3072 + kk] * w[q]; a4 += sl[4096 + kk] * w[q]; } }
            red[(ks * 5 + 0) * 64 + cl] = a0; red[(ks * 5 + 1) * 64 + cl] = a1; red[(ks * 5 + 2) * 64 + cl] = a2; red[(ks * 5 + 3) * 64 + cl] = a3; red[(ks * 5 + 4) * 64 + cl] = a4;
            __syncthreads();
            if (tid < 320) { const int s = tid >> 6; float v = inptr(F, 5)[l * MODW + j0 + cl];
                for (int q = 0; q < 8; ++q) v += red[(q * 5 + s) * 64 + cl];
                mod[(size_t)(l * 5 + s) * MODW + j0 + cl] = v; }
            __syncthreads();
        }
    }
    __syncthreads();
    if (F.bx == F.G - 1) {
        float* rope = (float*)(ws + WS_ROPE);
        for (int i = tid; i < 1024; i += NTHR) { const int pos = i >> 3, f = i & 7; const float inv = exp2f(-(float)f * (13.287712379549449f / 8.0f));
            const float rev = (float)pos * inv * 0.15915494309189535f; rope[2 * i] = __builtin_amdgcn_cosf(rev); rope[2 * i + 1] = __builtin_amdgcn_sinf(rev); }
    }
    if (F.bx == 0) { unsigned* bw = (unsigned*)(ws + WS_BAR); for (int i = tid; i < 3456; i += NTHR) bw[i] = 0u; }
    const int gt = F.bx * NTHR + tid, GT = F.G * NTHR;
    { float* z = (float*)(ws + WS_STAT); for (int i = gt; i < 8 * MT; i += GT) z[i] = 0.f; }
    for (int l = 0; l < 2; ++l) {
        v4u zz = {0u, 0u, 0u, 0u};
        bf16* wi = (bf16*)(ws + WS_WIN) + (size_t)l * NP * DM + (size_t)2208 * DM;
        for (int i = gt; i < 96 * DM / 8; i += GT) *(v4u*)(wi + (size_t)i * 8) = zz;
        bf16* wq = (bf16*)(ws + WS_WUQ) + (size_t)l * 512 * 256 + (size_t)384 * 256;
        for (int i = gt; i < 128 * 256 / 8; i += GT) *(v4u*)(wq + (size_t)i * 8) = zz;
        bf16* wk = (bf16*)(ws + WS_WUKV) + (size_t)l * 512 * 256;
        for (int i = gt; i < 512 * 16; i += GT) *(v4u*)(wk + (size_t)(i >> 4) * 256 + 128 + (i & 15) * 8) = zz;
    }
    float* scr = (float*)(F.lds + wave * 16384);
    const int gw = F.vcu * NWAVES + wave, NGW = F.G * NWAVES;
    constexpr int I_A = 16 * 37, I_B = 16 * 16, I_Q = 4 * 12, I_KV = 2 * 16, I_O = 16 * 32, I_1 = 16 * 128, I_2 = 64 * 32, I_FZ = 1024;
    constexpr int I_L = I_A + I_B + I_Q + I_KV + I_O + I_1 + I_2 + I_FZ;
    for (int it = gw; it < 2 * I_L; it += NGW) {
        const int l = it / I_L; int r = it % I_L;
        const float* win = inptr(F, 8) + (size_t)l * DM * D_IN; bf16* winT = (bf16*)(ws + WS_WIN) + (size_t)l * NP * DM;
        if (r < I_A) { tr_item(win, D_IN, 1184, winT, DM, 0, scr, r, lane, nullptr); continue; } r -= I_A;
        if (r < I_B) { tr_item(win + 1440, D_IN, 512, winT, DM, PC_CV, scr, r, lane, nullptr); continue; } r -= I_B;
        if (r < I_Q) { tr_item(inptr(F, 10) + (size_t)l * 256 * 384, 384, 384, (bf16*)(ws + WS_WUQ) + (size_t)l * 512 * 256, 256, 0, scr, r, lane, inptr(F, 9) + l * 256); continue; } r -= I_Q;
        if (r < I_KV) { tr_item(inptr(F, 12) + (size_t)l * 128 * 512, 512, 512, (bf16*)(ws + WS_WUKV) + (size_t)l * 512 * 256, 256, 0, scr, r, lane, inptr(F, 11) + l * 128); continue; } r -= I_KV;
        if (r < I_O) { tr_item(inptr(F, 18) + (size_t)l * DM * DM, DM, DM, (bf16*)(ws + WS_WOUT) + (size_t)l * DM * DM, DM, 0, scr, r, lane, nullptr); continue; } r -= I_O;
        if (r < I_1) { tr_item(inptr(F, 19) + (size_t)l * DM * DFF, DFF, DFF, (bf16*)(ws + WS_W1) + (size_t)l * DM * DFF, DM, 0, scr, r, lane, nullptr); continue; } r -= I_1;
        if (r < I_2) { tr_item(inptr(F, 20) + (size_t)l * DFF * DM, DM, DM, (bf16*)(ws + WS_W2) + (size_t)l * DM * DFF, DFF, 0, scr, r, lane, nullptr); continue; } r -= I_2;
        fz_item(win, winT, tab64, r, lane);
    }
}

__device__ __forceinline__ void phase_xs(Ctx& F, const float* xlat, const float* xctx, const float* g, const float* modl, float* ss1, bf16* XS) {
    refresh(F);
    const int gw = F.vcu * NWAVES + F.wave, NGW = F.G * NWAVES, lane = F.lane;
    for (int row0 = 2 * gw; row0 < MT; row0 += 2 * NGW) {
        f32x4 v[2][4]; float ss[2] = {0.f, 0.f};
#pragma unroll
        for (int q = 0; q < 2; ++q) { const int row = row0 + q;
            const float* xr = row < ML ? xlat + (size_t)row * DM : xctx + (size_t)(row - ML) * DM;
#pragma unroll
            for (int j = 0; j < 4; ++j) v[q][j] = __builtin_nontemporal_load((const f32x4*)(xr + 256 * j + 4 * lane)); }
#pragma unroll
        for (int q = 0; q < 2; ++q) { const int row = row0 + q; const int s = row < ML ? (row >> 13) : 4;
            const float* sc = modl + s * MODW + DM;
#pragma unroll
            for (int j = 0; j < 4; ++j) ss[q] += (v[q][j][0] * v[q][j][0] + v[q][j][1] * v[q][j][1]) + (v[q][j][2] * v[q][j][2] + v[q][j][3] * v[q][j][3]);
            ss[q] = wave_sum(ss[q]);
            if (lane == 0) ss1[row] = ss[q];
#pragma unroll
            for (int j = 0; j < 4; ++j) { const int c = 256 * j + 4 * lane;
                const f32x4 gg = *(const f32x4*)(g + c), s1 = *(const f32x4*)(sc + c);
                const f32x4 y = v[q][j] * gg * (s1 + 1.0f);
                v2u w; w.x = pk2(y[0], y[1]); w.y = pk2(y[2], y[3]); *(v2u*)(XS + (size_t)row * DM + c) = w; } }
    }
}
constexpr int KSPLIT = 8;
__device__ __forceinline__ void phase_xs_ctx(Ctx& F, float* xctx, const float* part, const float* gate4, const float* g, const float* modl, float* ss1, bf16* XS) {
    refresh(F);
    const int gw = F.vcu * NWAVES + F.wave, NGW = F.G * NWAVES, lane = F.lane;
    for (int r = gw; r < MC; r += NGW) {
        const int row = ML + r;
        float* xr = xctx + (size_t)r * DM; const float* sc = modl + 4 * MODW + DM;
        f32x4 v[4]; float ss = 0.f;
#pragma unroll
        for (int j = 0; j < 4; ++j) { const int c = 256 * j + 4 * lane; f32x4 a = {0.f, 0.f, 0.f, 0.f};
#pragma unroll
            for (int ks = 0; ks < KSPLIT; ++ks) a += *(const f32x4*)(part + ((size_t)ks * MC + r) * DM + c);
            v[j] = *(const f32x4*)(xr + c) + *(const f32x4*)(gate4 + c) * a; *(f32x4*)(xr + c) = v[j];
            ss += (v[j][0] * v[j][0] + v[j][1] * v[j][1]) + (v[j][2] * v[j][2] + v[j][3] * v[j][3]); }
        ss = wave_sum(ss);
        if (lane == 0) ss1[row] = ss;
#pragma unroll
        for (int j = 0; j < 4; ++j) { const int c = 256 * j + 4 * lane;
            const f32x4 gg = *(const f32x4*)(g + c), s1 = *(const f32x4*)(sc + c);
            const f32x4 y = v[j] * gg * (s1 + 1.0f);
            v2u w; w.x = pk2(y[0], y[1]); w.y = pk2(y[2], y[3]); *(v2u*)(XS + (size_t)row * DM + c) = w; }
    }
}
__device__ __forceinline__ void phase_bias(Ctx& F) {
    refresh(F);
    unsigned char* ws = F.ws;
    const int gw = F.vcu * NWAVES + F.wave, NGW = F.G * NWAVES, lane = F.lane;
    for (int grp = 0; grp < 4; ++grp) {
        const int l = grp >> 1, which = grp & 1, nrows = which ? DFF : NP;
        const float* shb = (const float*)(ws + WS_MOD) + (size_t)l * 5 * MODW + (which ? 3 * DM : 0) + 16 * lane;
        const bf16* W = which ? (const bf16*)(ws + WS_W1) + (size_t)l * DM * DFF : (const bf16*)(ws + WS_WIN) + (size_t)l * NP * DM;
        float* outp = which ? (float*)(ws + WS_B2) + (size_t)l * 5 * DFF : (float*)(ws + WS_B1) + (size_t)l * 5 * NP;
        for (int n0 = gw; n0 < nrows; n0 += 2 * NGW) {
            const int n1 = n0 + NGW; const bool h1 = n1 < nrows; const int n1c = h1 ? n1 : n0;
            const v4u wa0 = *(const v4u*)(W + (size_t)n0 * DM + 16 * lane), wa1 = *(const v4u*)(W + (size_t)n0 * DM + 16 * lane + 8);
            const v4u wb0 = *(const v4u*)(W + (size_t)n1c * DM + 16 * lane), wb1 = *(const v4u*)(W + (size_t)n1c * DM + 16 * lane + 8);
            float fa[16], fb[16];
#pragma unroll
            for (int q = 0; q < 4; ++q) { fa[2 * q] = __builtin_bit_cast(float, wa0[q] << 16); fa[2 * q + 1] = __builtin_bit_cast(float, wa0[q] & 0xffff0000u);
                fa[8 + 2 * q] = __builtin_bit_cast(float, wa1[q] << 16); fa[8 + 2 * q + 1] = __builtin_bit_cast(float, wa1[q] & 0xffff0000u);
                fb[2 * q] = __builtin_bit_cast(float, wb0[q] << 16); fb[2 * q + 1] = __builtin_bit_cast(float, wb0[q] & 0xffff0000u);
                fb[8 + 2 * q] = __builtin_bit_cast(float, wb1[q] << 16); fb[8 + 2 * q + 1] = __builtin_bit_cast(float, wb1[q] & 0xffff0000u); }
#pragma unroll
            for (int sI = 0; sI < 5; ++sI) { float a = 0.f, b = 0.f;
#pragma unroll
                for (int q = 0; q < 4; ++q) { const f32x4 hv = *(const f32x4*)(shb + sI * MODW + 4 * q);
                    a += (hv[0] * fa[4 * q] + hv[1] * fa[4 * q + 1]) + (hv[2] * fa[4 * q + 2] + hv[3] * fa[4 * q + 3]);
                    b += (hv[0] * fb[4 * q] + hv[1] * fb[4 * q + 1]) + (hv[2] * fb[4 * q + 2] + hv[3] * fb[4 * q + 3]); }
                a = wave_sum(a); b = wave_sum(b);
                if (lane == 0) { outp[sI * nrows + n0] = a; if (h1) outp[sI * nrows + n1] = b; } }
        }
    }
}
__device__ __forceinline__ void phase_final(Ctx& F, const bf16* xr, float* out, const float* g) {
    refresh(F);
    const int gw = F.vcu * NWAVES + F.wave, NGW = F.G * NWAVES, lane = F.lane;
    f32x4 gg[4];
#pragma unroll
    for (int j = 0; j < 4; ++j) gg[j] = *(const f32x4*)(g + 256 * j + 4 * lane);
    for (int row0 = 4 * gw; row0 < ML; row0 += 4 * NGW) {
        v2u w[4][4];
#pragma unroll
        for (int q = 0; q < 4; ++q)
#pragma unroll
            for (int j = 0; j < 4; ++j) w[q][j] = *(const v2u*)(xr + (size_t)(row0 + q) * DM + 256 * j + 4 * lane);
#pragma unroll
        for (int q = 0; q < 4; ++q) { f32x4 v[4]; float ss = 0.f;
#pragma unroll
            for (int j = 0; j < 4; ++j) { v[j] = (f32x4){__builtin_bit_cast(float, w[q][j].x << 16), __builtin_bit_cast(float, w[q][j].x & 0xffff0000u), __builtin_bit_cast(float, w[q][j].y << 16), __builtin_bit_cast(float, w[q][j].y & 0xffff0000u)};
                ss += (v[j][0] * v[j][0] + v[j][1] * v[j][1]) + (v[j][2] * v[j][2] + v[j][3] * v[j][3]); }
            const float r = 1.0f / sqrtf(wave_sum(ss) * (1.0f / DM) + EPS);
#pragma unroll
            for (int j = 0; j < 4; ++j) __builtin_nontemporal_store(v[j] * r * gg[j], (f32x4*)(out + (size_t)(row0 + q) * DM + 256 * j + 4 * lane)); }
    }
}

__device__ __forceinline__ void conv_unit(Ctx& F, const bf16* P, bf16* O, int seq_row0, int seq_len, int t0, const float* wdw, const float* bdw, const float* lng, const float* lnb) {
    refresh(F);
    float* y = (float*)F.lds;
    const int tid = F.tid;
    {
        v4u av[6], gv[6]; bool okv[6];
#pragma unroll
        for (int q = 0; q < 6; ++q) { const int i = tid + q * NTHR, r = i >> 5, c8 = (i & 31) * 8, t = t0 - 15 + r;
            okv[q] = (i < 94 * 32) && t >= 0 && t < seq_len;
            const bf16* pr = P + (size_t)(seq_row0 + (okv[q] ? t : 0)) * NP + PC_CV + c8;
            av[q] = okv[q] ? *(const v4u*)pr : (v4u){0u, 0u, 0u, 0u}; gv[q] = okv[q] ? *(const v4u*)(pr + 256) : (v4u){0u, 0u, 0u, 0u}; }
#pragma unroll
        for (int q = 0; q < 6; ++q) { const int i = tid + q * NTHR, r = i >> 5, c8 = (i & 31) * 8;
            float o[8];
#pragma unroll
            for (int w = 0; w < 4; ++w) { const unsigned aw = av[q][w], gw = gv[q][w];
                const float a0 = __builtin_bit_cast(float, aw << 16), a1 = __builtin_bit_cast(float, aw & 0xffff0000u), g0 = __builtin_bit_cast(float, gw << 16), g1 = __builtin_bit_cast(float, gw & 0xffff0000u);
                o[2 * w] = okv[q] ? a0 / (1.0f + __expf(-g0)) : 0.f; o[2 * w + 1] = okv[q] ? a1 / (1.0f + __expf(-g1)) : 0.f; }
            if (i < 94 * 32) { *(f32x4*)(y + r * 256 + c8) = (f32x4){o[0], o[1], o[2], o[3]}; *(f32x4*)(y + r * 256 + c8 + 4) = (f32x4){o[4], o[5], o[6], o[7]}; } }
    }
    __syncthreads();
    const int c = tid & 255, hf = tid >> 8;
    float w[31];
#pragma unroll
    for (int k = 0; k < 31; ++k) w[k] = wdw[k * 256 + c];
    const float bb = bdw[c];
    float outv[32];
#pragma unroll
    for (int tt = 0; tt < 32; ++tt) { float a = bb; const float* yp = y + (hf * 32 + tt) * 256 + c;
#pragma unroll
        for (int k = 0; k < 31; ++k) a += w[k] * yp[k * 256];
        outv[tt] = a; }
    __syncthreads();
#pragma unroll
    for (int tt = 0; tt < 32; ++tt) y[(hf * 32 + tt) * 256 + c] = outv[tt];
    __syncthreads();
    const int lane = F.lane, wave = F.wave;
    const f32x4 gg = *(const f32x4*)(lng + 4 * lane), be = *(const f32x4*)(lnb + 4 * lane);
    for (int q = 0; q < 8; ++q) {
        const int tt = wave * 8 + q;
        const f32x4 v = *(const f32x4*)(y + tt * 256 + 4 * lane);
        const float mu = wave_sum((v[0] + v[1]) + (v[2] + v[3])) * (1.0f / 256.0f);
        const f32x4 d = v - mu;
        const float var = wave_sum((d[0] * d[0] + d[1] * d[1]) + (d[2] * d[2] + d[3] * d[3])) * (1.0f / 256.0f);
        const float rs = 1.0f / sqrtf(var + EPS);
        f32x4 o = d * rs * gg + be;
#pragma unroll
        for (int j = 0; j < 4; ++j) o[j] = siluf(o[j]);
        v2u wv; wv.x = pk2(o[0], o[1]); wv.y = pk2(o[2], o[3]);
        *(v2u*)(O + (size_t)(seq_row0 + t0 + tt) * DM + 768 + 4 * lane) = wv;
    }
    __syncthreads();
}

__device__ __forceinline__ void fourier_step1(Ctx& F, const bf16* P, bf16* Y) {
    refresh(F);
    using namespace att;
    const int tid = F.tid, lane = F.lane, wave = F.wave, r32 = lane & 31, hi = lane >> 5;
    bf16x8 afr[16];
    { const int k1 = 16 * wave + (r32 & 15); const bool isV = r32 >= 16;
#pragma unroll
      for (int s = 0; s < 16; ++s) {
        unsigned wv[4];
#pragma unroll
        for (int i2 = 0; i2 < 4; ++i2) { float e[2];
#pragma unroll
            for (int q = 0; q < 2; ++q) { const int kk = 16 * s + 8 * hi + 2 * i2 + q, part = kk >> 7, n1 = kk & 127; const int t = (k1 * n1) & 127;
                const float cs = __builtin_amdgcn_cosf((float)t * (1.0f / 128.0f)), sn = __builtin_amdgcn_sinf((float)t * (1.0f / 128.0f));
                e[q] = isV ? (part ? cs : sn) : (part ? -sn : cs); }
            wv[i2] = pk2(e[0], e[1]); }
        u32x4 w = {wv[0], wv[1], wv[2], wv[3]}; afr[s] = *reinterpret_cast<bf16x8*>(&w);
      } }
    char* img = F.lds;
    const int vb = (int)(uintptr_t)img + v_rd_base(lane);
    for (int prob = F.vcu; prob < 256; prob += F.G) {
        const int b = prob >> 6, n2 = prob & 63;
        for (int ch = 0; ch < 2; ++ch) {
#pragma unroll
            for (int q = 0; q < 8; ++q) { const int idx = q * NTHR + tid, kb = idx >> 10, k = (idx >> 4) & 63, c = (idx & 15) * 8;
                const int part = kb >> 1, n1 = (kb & 1) * 64 + k;
                const bf16x8 v = ld8(P + (size_t)(b * SEQ + 64 * n1 + n2) * NP + (part ? PC_ZI : PC_ZR) + 128 * ch + c);
                *(bf16x8*)(img + kb * 16384 + v_st(k, c)) = v; }
            __syncthreads();
#define F1_Q(Q, D0) do { \
                const s16x4 l0 = tr_read<(Q) * 16384 + v_rd_off(D0, 0, 0)>(vb), h0 = tr_read<(Q) * 16384 + v_rd_off(D0, 0, 1)>(vb), l1 = tr_read<(Q) * 16384 + v_rd_off(D0, 1, 0)>(vb), h1 = tr_read<(Q) * 16384 + v_rd_off(D0, 1, 1)>(vb); \
                const s16x4 l2 = tr_read<(Q) * 16384 + v_rd_off(D0, 2, 0)>(vb), h2 = tr_read<(Q) * 16384 + v_rd_off(D0, 2, 1)>(vb), l3 = tr_read<(Q) * 16384 + v_rd_off(D0, 3, 0)>(vb), h3 = tr_read<(Q) * 16384 + v_rd_off(D0, 3, 1)>(vb); \
                asm volatile("s_waitcnt lgkmcnt(0)" ::: "memory"); SBAR(); \
                acc = __builtin_amdgcn_mfma_f32_32x32x16_bf16(afr[4 * (Q) + 0], PKLH(l0, h0), acc, 0, 0, 0); acc = __builtin_amdgcn_mfma_f32_32x32x16_bf16(afr[4 * (Q) + 1], PKLH(l1, h1), acc, 0, 0, 0); \
                acc = __builtin_amdgcn_mfma_f32_32x32x16_bf16(afr[4 * (Q) + 2], PKLH(l2, h2), acc, 0, 0, 0); acc = __builtin_amdgcn_mfma_f32_32x32x16_bf16(afr[4 * (Q) + 3], PKLH(l3, h3), acc, 0, 0, 0); } while (0)
#define F1_D0(D0) do { f32x16 acc = {}; \
            F1_Q(0, D0); F1_Q(1, D0); F1_Q(2, D0); F1_Q(3, D0); \
            const int col = 128 * ch + 32 * (D0) + r32; \
            _Pragma("unroll") for (int r = 0; r < 8; ++r) { const int k1 = 16 * wave + crow(r, hi); const float rev = (float)(k1 * n2) * (1.0f / 8192.0f); \
                const float cb = __builtin_amdgcn_cosf(rev), sb = __builtin_amdgcn_sinf(rev); const float U = acc[r], V = acc[r + 8]; \
                bf16* yp = Y + ((size_t)((b * 128 + k1) * 2) * 64 + n2) * 256 + col; \
                yp[0] = (bf16)f2bf(U * cb - V * sb); yp[(size_t)64 * 256] = (bf16)f2bf(U * sb + V * cb); } } while (0)
            F1_D0(0); F1_D0(1); F1_D0(2); F1_D0(3);
#undef F1_D0
#undef F1_Q
            __syncthreads();
        }
    }
}
__device__ __forceinline__ void fourier_step2(Ctx& F, const bf16* Y, bf16* O) {
    refresh(F);
    using namespace att;
    const int tid = F.tid, lane = F.lane, wave = F.wave, r32 = lane & 31, hi = lane >> 5;
    bf16x8 afr[2][8];
#pragma unroll
    for (int mt = 0; mt < 2; ++mt)
#pragma unroll
      for (int s = 0; s < 8; ++s) { const int k2 = 32 * mt + r32;
        unsigned wv[4];
#pragma unroll
        for (int i2 = 0; i2 < 4; ++i2) { float e[2];
#pragma unroll
            for (int q = 0; q < 2; ++q) { const int kk = 16 * s + 8 * hi + 2 * i2 + q, part = kk >> 6, n2 = kk & 63; const int t = (k2 * n2) & 63;
                e[q] = part ? -__builtin_amdgcn_sinf((float)t * (1.0f / 64.0f)) : __builtin_amdgcn_cosf((float)t * (1.0f / 64.0f)); }
            wv[i2] = pk2(e[0], e[1]); }
        u32x4 w = {wv[0], wv[1], wv[2], wv[3]}; afr[mt][s] = *reinterpret_cast<bf16x8*>(&w); }
    char* img = F.lds;
    const int ch = wave >> 2, d0 = wave & 3;
    const int vb = (int)(uintptr_t)img + v_rd_base(lane) + ch * 32768 + d0 * 512;
    const float scale = 0.0013810679320049757f;
    for (int prob = F.vcu; prob < 512; prob += F.G) {
        const int b = prob >> 7, k1 = prob & 127;
        const bf16* src = Y + (size_t)((b * 128 + k1) * 2) * 64 * 256;
#pragma unroll
        for (int q = 0; q < 8; ++q) { const int idx = q * NTHR + tid, key = idx >> 5, c = (idx & 31) * 8;
            const bf16x8 v = ld8(src + (size_t)key * 256 + c);
            *(bf16x8*)(img + (c >> 7) * 32768 + (key >> 6) * 16384 + v_st(key & 63, c & 127)) = v; }
        __syncthreads();
        f32x16 acc0 = {}, acc1 = {};
#define F2_S(S, KB, KS) do { const s16x4 lo = tr_read<(KB) * 16384 + v_rd_off(0, KS, 0)>(vb), hh = tr_read<(KB) * 16384 + v_rd_off(0, KS, 1)>(vb); \
            asm volatile("s_waitcnt lgkmcnt(0)" ::: "memory"); SBAR(); const bf16x8 bb = PKLH(lo, hh); \
            acc0 = __builtin_amdgcn_mfma_f32_32x32x16_bf16(afr[0][S], bb, acc0, 0, 0, 0); acc1 = __builtin_amdgcn_mfma_f32_32x32x16_bf16(afr[1][S], bb, acc1, 0, 0, 0); } while (0)
        F2_S(0, 0, 0); F2_S(1, 0, 1); F2_S(2, 0, 2); F2_S(3, 0, 3); F2_S(4, 1, 0); F2_S(5, 1, 1); F2_S(6, 1, 2); F2_S(7, 1, 3);
#undef F2_S
        const int col = 512 + 32 * wave + r32;
#pragma unroll
        for (int r = 0; r < 16; ++r) { const int k2 = crow(r, hi);
            O[(size_t)(b * SEQ + k1 + 128 * k2) * DM + col] = (bf16)f2bf(acc0[r] * scale);
            O[(size_t)(b * SEQ + k1 + 128 * (k2 + 32)) * DM + col] = (bf16)f2bf(acc1[r] * scale); }
        __syncthreads();
    }
}
__device__ __forceinline__ void fourier_ctx(Ctx& F, const bf16* P, bf16* O) {
    refresh(F);
    float* tab = (float*)(F.lds + MISC_OFF + 512);
    const int tid = F.tid;
    if (tid < 256) tab[tid] = __builtin_amdgcn_cosf((float)tid * (1.0f / 256.0f));
    __syncthreads();
    const int col = tid & 255, kh = tid >> 8;
    for (int item = F.vcu; item < 256; item += F.G) {
        const int b = item >> 6, kq = (item & 63) * 4 + kh * 2;
        float a0 = 0.f, a1 = 0.f;
        const bf16* src = P + (size_t)(ML + b * CTXL) * NP;
        for (int n8 = 0; n8 < 256; n8 += 8) {
            unsigned short zr_[8], zi_[8];
#pragma unroll
            for (int q = 0; q < 8; ++q) { zr_[q] = src[(size_t)(n8 + q) * NP + PC_ZR + col]; zi_[q] = src[(size_t)(n8 + q) * NP + PC_ZI + col]; }
#pragma unroll
            for (int q = 0; q < 8; ++q) { const int n = n8 + q; const float zr = bf2f(zr_[q]), zi = bf2f(zi_[q]);
                const int i0 = (kq * n) & 255, i1 = ((kq + 1) * n) & 255;
                a0 += zr * tab[i0] - zi * tab[(i0 + 192) & 255];
                a1 += zr * tab[i1] - zi * tab[(i1 + 192) & 255]; }
        }
        O[(size_t)(ML + b * CTXL + kq) * DM + 512 + col] = (bf16)f2bf(a0 * (1.0f / 128.0f));
        O[(size_t)(ML + b * CTXL + kq + 1) * DM + 512 + col] = (bf16)f2bf(a1 * (1.0f / 128.0f));
    }
}

#define LAS __attribute__((address_space(3)))
#define XB_TMO      128
#define XB_XCNT(j)  (256  + 64 * (j))
#define XB_XSUB(j)  (1280 + 64 * (j))
#define XB_XGEN(j)  (2304 + 64 * (j))
#define XB_TOP      3328
#define XB_TOPGEN   3392
#define XCD_BAR_WORDS 3456
#define XB_SPIN_CAP (1u << 18)

__device__ __forceinline__ unsigned xb_ld(unsigned* p)              { return __hip_atomic_load(p, __ATOMIC_RELAXED, __HIP_MEMORY_SCOPE_AGENT); }
__device__ __forceinline__ unsigned xb_add(unsigned* p, unsigned v) { return __hip_atomic_fetch_add(p, v, __ATOMIC_RELAXED, __HIP_MEMORY_SCOPE_AGENT); }
__device__ __forceinline__ unsigned xb_xcc_id() { return (unsigned)__builtin_amdgcn_s_getreg((3 << 11) | 20) & 0xFu; }
#define XB_SPIN(cond, bar) do { unsigned _sp = 0; while (cond) { __builtin_amdgcn_s_sleep(1); \
    if ((++_sp & 255u) == 0u) { if (xb_ld(&(bar)[XB_TMO])) break; if (_sp > XB_SPIN_CAP) { atomicAdd(&(bar)[XB_TMO], 1u); break; } } } } while (0)

struct XcdBarrier {
    unsigned* bar; unsigned x;
    volatile LAS unsigned* st;
};

__device__ __forceinline__ XcdBarrier xcd_barrier_post(unsigned* bar, volatile LAS unsigned* st) {
    XcdBarrier b; b.bar = bar; b.x = xb_xcc_id(); b.st = st;
    if (threadIdx.x == 0) (void)xb_add(&bar[XB_XCNT(b.x)], 1u);
    return b;
}
__device__ __forceinline__ void xcd_barrier_complete(unsigned* bar, unsigned x, unsigned& nloc, unsigned& nx) {
    const unsigned G = gridDim.x * gridDim.y * gridDim.z;
    unsigned sum, cnt, mine, sp = 0u;
    for (;;) {
        sum = 0u; cnt = 0u; mine = 0u;
#pragma unroll
        for (unsigned j = 0; j < 16; ++j) { const unsigned c = xb_ld(&bar[XB_XCNT(j)]); sum += c; cnt += (c > 0u) ? 1u : 0u; mine = (j == x) ? c : mine; }
        if (sum == G) break;
        __builtin_amdgcn_s_sleep(1);
        if ((++sp & 255u) == 0u) { if (xb_ld(&bar[XB_TMO])) break; if (sp > XB_SPIN_CAP) { atomicAdd(&bar[XB_TMO], 1u); break; } }
    }
    nloc = mine > 0u ? mine : 1u; nx = cnt > 0u ? cnt : 1u;
}

__device__ __forceinline__ void xcd_barrier(const XcdBarrier& b) {
    asm volatile("s_waitcnt vmcnt(0)" ::: "memory");
    __syncthreads();
    if (threadIdx.x == 0) {
        unsigned* bar = b.bar;
        __builtin_amdgcn_s_waitcnt(0);
        unsigned nloc = b.st[0], nx = b.st[1];
        if (nloc == 0u) { xcd_barrier_complete(bar, b.x, nloc, nx); b.st[0] = nloc; b.st[1] = nx; }
        const unsigned old = xb_add(&bar[XB_XSUB(b.x)], 1u);
        const unsigned gen = old / nloc;
        if (old + 1u == (gen + 1u) * nloc) {
            __builtin_amdgcn_fence(__ATOMIC_RELEASE, "agent");
            asm volatile("s_waitcnt vmcnt(0)" ::: "memory");
            const unsigned og = xb_add(&bar[XB_TOP], 1u);
            const unsigned tg = og / nx;
            if (og + 1u == (tg + 1u) * nx) xb_add(&bar[XB_TOPGEN], 1u);
            else XB_SPIN(xb_ld(&bar[XB_TOPGEN]) == tg, bar);
            __builtin_amdgcn_fence(__ATOMIC_ACQUIRE, "agent");
            xb_add(&bar[XB_XGEN(b.x)], 1u);
            asm volatile("s_waitcnt vmcnt(0)" ::: "memory");
        } else {
            XB_SPIN(xb_ld(&bar[XB_XGEN(b.x)]) == gen, bar);
            __builtin_amdgcn_fence(__ATOMIC_ACQUIRE, "agent");
            asm volatile("s_waitcnt vmcnt(0)" ::: "memory");
        }
    }
    __syncthreads();
}


__device__ __forceinline__ void run_phase(Ctx& F0, const int p) {
    Ctx F = F0; F.argoff = (unsigned)(uintptr_t)F.lds + ARGS_OFF; asm volatile("" : "+s"(F.G), "+s"(F.vcu), "+s"(F.bx), "+s"(F.argoff));
    unsigned long long wsi_ = (unsigned long long)(uintptr_t)inptr(F, 23); asm volatile("" : "+s"(wsi_));
    unsigned char* ws = (unsigned char*)(__attribute__((address_space(1))) unsigned char*)wsi_;
    F.ws = ws;
    PG8_LAS unsigned char* ldsl = (PG8_LAS unsigned char*)(uintptr_t)(unsigned)(uintptr_t)F.lds;
    if (p == 0) {
#ifndef NO_PRO
        phase_prologue(F);
#endif
        return;
    }
    if (p == 1) {
        phase_xs(F, inptr(F, 0), inptr(F, 2), inptr(F, 6), (const float*)(ws + WS_MOD), STATP(ws, 0, 2), (bf16*)(ws + WS_XN));
        phase_bias(F);
        return;
    }
    if (p == 8) { phase_xs_ctx(F, (float*)(ws + WS_XC), (const float*)(ws + WS_Y), (const float*)(ws + WS_MOD) + (size_t)4 * MODW + 5 * DM, inptr(F, 6) + DM, (const float*)(ws + WS_MOD) + (size_t)5 * MODW, STATP(ws, 1, 2), (bf16*)(ws + WS_XN)); return; }
    if (p == 15) { phase_final(F, (const bf16*)(ws + WS_XR), (float*)inptr(F, 22), inptr(F, 21)); return; }
    const int l = (p >= 9) ? 1 : 0, sub = (p >= 9) ? (p - 8) : (p - 1);
    const bool last = (l == DEPTH - 1);
    const int Mrest = last ? ML : MT;
    if (sub == 1) {
        pg8::Gemm g{(const bf16*)(ws + WS_XN), (const bf16*)(ws + WS_WIN) + (size_t)l * NP * DM}; pg8::StaticOrder S; S.init(MT, NP, F.G, F.bx);
        pg8::EpiWin E{(bf16*)(ws + WS_P), (bf16*)(ws + WS_K), STATP(ws, l, 0), STATP(ws, l, 1), (const float*)(ws + WS_ROPE), STATP(ws, l, 2), (const float*)(ws + WS_B1) + (size_t)l * 5 * NP};
        pg8::gemm_phase<pg8::EpiWin, true, DM, DM, DM>(ldsl, g, S, E);
    } else if (sub == 2) {
        bf16* Pb = (bf16*)(ws + WS_P); bf16* Ob = (bf16*)(ws + WS_O);
#ifndef NO_GQ
        { pg8::Gemm g{Pb + PC_QA, (const bf16*)(ws + WS_WUQ) + (size_t)l * 512 * 256}; pg8::StaticOrder S; S.init(MT, 512, F.G, F.bx);
          pg8::EpiQ E{(bf16*)(ws + WS_Q), STATP(ws, l, 0), (const float*)(ws + WS_ROPE)}; pg8::gemm_phase<pg8::EpiQ, true, 256, NP, 256>(ldsl, g, S, E); }
#endif
#ifndef NO_GKV
        { pg8::Gemm g{Pb + PC_KVA, (const bf16*)(ws + WS_WUKV) + (size_t)l * 512 * 256}; pg8::StaticOrder S; S.init(MT, 512, F.G, F.G - 1 - F.bx);
          pg8::EpiKV E{(bf16*)(ws + WS_K), (bf16*)(ws + WS_V), STATP(ws, l, 1)}; pg8::gemm_phase<pg8::EpiKV, true, 256, NP, 256>(ldsl, g, S, E); }
#endif
        __syncthreads();
#ifndef NO_F1
        for (int rep_ = 0; rep_ < (PROBE_PART == 1 ? 2 : 1); ++rep_) {
        fourier_step1(F, Pb, (bf16*)(ws + WS_Y));
        if (!last) fourier_ctx(F, Pb, Ob);
        __syncthreads(); }
#endif
        __syncthreads();
#ifndef NO_CONV
        for (int rep_ = 0; rep_ < (PROBE_PART == 3 ? 2 : 1); ++rep_)
        { const int nun = last ? 512 : 528;
          const float* wdw = inptr(F, 14) + (size_t)l * 31 * 256; const float* bdw = inptr(F, 15) + l * 256; const float* lng = inptr(F, 16) + l * 256; const float* lnb = inptr(F, 17) + l * 256;
          for (int u = F.vcu; u < nun; u += F.G) {
              if (u < 512) conv_unit(F, Pb, Ob, (u >> 7) * SEQ, SEQ, (u & 127) * 64, wdw, bdw, lng, lnb);
              else { const int v = u - 512; conv_unit(F, Pb, Ob, ML + (v >> 2) * CTXL, CTXL, (v & 3) * 64, wdw, bdw, lng, lnb); }
          } }
#endif
#ifndef NO_NA
        for (int rep_ = 0; rep_ < (PROBE_PART == 2 ? 2 : 1); ++rep_)
        { float* rpb = (float*)(F.lds + MISC_OFF + 2048);
          for (int i = F.tid; i < 4 * 15 * 31; i += NTHR) rpb[i] = inptr(F, 13)[(size_t)l * 4 * 15 * 31 + i];
          __syncthreads();
          for (int u = F.vcu; u < 512; u += F.G) {
              const int bh = u >> 5, rb = u & 31, b = bh >> 2, h = bh & 3, r0 = 4 * rb, rs0 = min(max(r0 - 4, 0), 116);
              att::attn_unit<64, 1, NP, NP, NP>(Pb + (size_t)(b * SEQ + r0 * 64) * NP + PC_NAQ + h * 64, Pb + PC_NAK + h * 64, Pb + PC_NAV + h * 64,
                                    ML + b * CTXL, 4, b * SEQ + rs0 * 64, 16, Ob + (size_t)(b * SEQ + r0 * 64) * DM + 256 + h * 64, F.lds, MISC_OFF + 2048 + h * 15 * 31 * 4, r0, rs0);
          }
          if (!last) for (int u = F.vcu; u < 16; u += F.G) {
              const int b = u >> 2, h = u & 3;
              att::attn_unit<64, 1, NP, NP, NP>(Pb + (size_t)(ML + b * CTXL) * NP + PC_NAQ + h * 64, Pb + PC_NAK + h * 64, Pb + PC_NAV + h * 64,
                                    ML + b * CTXL, 4, 0, 4, Ob + (size_t)(ML + b * CTXL) * DM + 256 + h * 64, F.lds, MISC_OFF + 2048, 0, 0);
          } }
#endif
    } else if (sub == 3) {
        bf16* Qb = (bf16*)(ws + WS_Q); bf16* Kb = (bf16*)(ws + WS_K); bf16* Vb = (bf16*)(ws + WS_V); bf16* Ob = (bf16*)(ws + WS_O);
#ifndef NO_MLA
        for (int u = F.vcu; u < 512; u += F.G) {
            const int bh = u >> 5, qb = u & 31, b = bh >> 2, h = bh & 3;
            att::attn_unit<96, 0, 384, 384, 256>(Qb + (size_t)(b * SEQ + qb * 256) * 384 + h * 96, Kb + h * 96, Vb + h * 64,
                                  b * SEQ, 128, ML + b * CTXL, 132, Ob + (size_t)(b * SEQ + qb * 256) * DM + h * 64, F.lds, 0, 0, 0);
        }
        if (!last) for (int u = F.vcu; u < 16; u += F.G) {
            const int b = u >> 2, h = u & 3;
            att::attn_unit<96, 0, 384, 384, 256>(Qb + (size_t)(ML + b * CTXL) * 384 + h * 96, Kb + h * 96, Vb + h * 64,
                                  ML + b * CTXL, 4, 0, 4, Ob + (size_t)(ML + b * CTXL) * DM + h * 64, F.lds, 0, 0, 0);
        }
#endif
#ifndef NO_F2
        fourier_step2(F, (const bf16*)(ws + WS_Y), Ob);
#endif
    } else if (sub == 4) {
        pg8::Gemm g{(const bf16*)(ws + WS_O), (const bf16*)(ws + WS_WOUT) + (size_t)l * DM * DM}; pg8::StaticOrder S; S.init(Mrest, DM, F.G, F.bx);
        if (l == 0) {
            pg8::EpiRes<false> E{inptr(F, 0), inptr(F, 2), (bf16*)(ws + WS_XR), (float*)(ws + WS_XC), (const float*)(ws + WS_MOD) + (size_t)l * 5 * MODW + 2 * DM,
                                 (bf16*)(ws + WS_XN), STATP(ws, l, 3), inptr(F, 7) + l * DM, (const float*)(ws + WS_MOD) + (size_t)l * 5 * MODW + 4 * DM};
            pg8::gemm_phase<pg8::EpiRes<false>, true, DM, DM, DM>(ldsl, g, S, E);
        } else {
            pg8::EpiRes<true> E{nullptr, nullptr, (bf16*)(ws + WS_XR), nullptr, (const float*)(ws + WS_MOD) + (size_t)l * 5 * MODW + 2 * DM,
                                (bf16*)(ws + WS_XN), STATP(ws, l, 3), inptr(F, 7) + l * DM, (const float*)(ws + WS_MOD) + (size_t)l * 5 * MODW + 4 * DM};
            pg8::gemm_phase<pg8::EpiRes<true>, true, DM, DM, DM>(ldsl, g, S, E);
        }
    } else if (sub == 5) {
        pg8::Gemm g{(const bf16*)(ws + WS_XN), (const bf16*)(ws + WS_W1) + (size_t)l * DM * DFF}; pg8::StaticOrder S; S.init(Mrest, DFF, F.G, F.bx);
        pg8::EpiFF1 E{(bf16*)(ws + WS_H), DFF, STATP(ws, l, 3), (const float*)(ws + WS_B2) + (size_t)l * 5 * DFF};
        pg8::gemm_phase<pg8::EpiFF1, true, DM, DM, DM>(ldsl, g, S, E);
    } else {
        pg8::Gemm g{(const bf16*)(ws + WS_H), (const bf16*)(ws + WS_W2) + (size_t)l * DM * DFF}; pg8::StaticOrder S; S.init(ML, DM, F.G, F.bx);
        pg8::EpiRes<true> E{nullptr, nullptr, (bf16*)(ws + WS_XR), nullptr, (const float*)(ws + WS_MOD) + (size_t)l * 5 * MODW + 5 * DM,
                      last ? (bf16*)nullptr : (bf16*)(ws + WS_XN), STATP(ws, last ? l : l + 1, 2), inptr(F, 6) + (last ? l : l + 1) * DM, (const float*)(ws + WS_MOD) + (size_t)(last ? l : l + 1) * 5 * MODW + DM};
        pg8::gemm_phase<pg8::EpiRes<true>, true, DFF, DFF, DFF>(ldsl, g, S, E);
        if (!last) {
            for (int ks = 0; ks < KSPLIT; ++ks) {
                int c = F.bx - 16 * ks; if (c < 0) c += F.G;
                pg8::EpiPart EA{(float*)(ws + WS_Y) + (size_t)ks * MC * DM};
                pg8::Gemm gk{(const bf16*)(ws + WS_H) + (size_t)ML * DFF + ks * (DFF / KSPLIT), (const bf16*)(ws + WS_W2) + (size_t)l * DM * DFF + ks * (DFF / KSPLIT)}; pg8::StaticOrder Sk; Sk.init(MC, DM, F.G, c);
                pg8::gemm_phase<pg8::EpiPart, true, DFF / KSPLIT, DFF, DFF>(ldsl, gk, Sk, EA);
            }
        }
    }
}

__global__ void __launch_bounds__(NTHR, 2) mk_fwd(Args args) {
    extern __shared__ __attribute__((aligned(16))) unsigned char lds_raw[];
    cg::grid_group grid = cg::this_grid();
    Ctx F; F.lds = (char*)lds_raw; F.tid = threadIdx.x; F.lane = F.tid & 63; F.wave = __builtin_amdgcn_readfirstlane(F.tid >> 6);
    F.G = gridDim.x; F.bx = blockIdx.x; { const int bx = blockIdx.x; F.vcu = (F.G % 8 == 0) ? (bx % 8) * (F.G / 8) + bx / 8 : bx; }
    F.ws = nullptr;
    if (threadIdx.x == 0) {
        unsigned long long* la = (unsigned long long*)(F.lds + ARGS_OFF);
#pragma unroll
        for (int i = 0; i < 22; ++i) la[i] = (unsigned long long)args.in[i];
        la[22] = (unsigned long long)args.out; la[23] = (unsigned long long)args.ws;
    }
    __syncthreads();
    volatile LAS unsigned* bst = (volatile LAS unsigned*)(uintptr_t)((unsigned)(uintptr_t)F.lds + ARGS_OFF + 256);
    if (threadIdx.x < 2) bst[threadIdx.x] = 0u;
    __syncthreads();
    XcdBarrier bar; bar.bar = nullptr; bar.x = 0; bar.st = bst;
    for (int p = args.ph_lo; p < args.ph_hi; ++p) {
        run_phase(F, p);
        if (p + 1 < args.ph_hi) {
            if (p == args.ph_lo) { grid.sync(); bar = xcd_barrier_post((unsigned*)(args.ws + WS_BAR), bst); }
            else xcd_barrier(bar);
        }
    }
}
constexpr int N_PHASES = 16;

extern "C" void kernel_launch(void* const* d_in, const int* in_sizes, int n_in, void* d_out, int out_size, void* d_ws, size_t ws_size, hipStream_t stream) {
    static int grid = 0;
    if (grid == 0) {
        if (n_in != 22 || out_size != ML * DM || ws_size < WS_END) { fprintf(stderr, "kernel_launch: unexpected shapes n_in %d out %d ws %zu (need %zu)\n", n_in, out_size, ws_size, (size_t)WS_END); grid = -1; return; }
        int dev = 0, cus = 0, per_cu = 0;
        hipGetDevice(&dev); hipDeviceGetAttribute(&cus, hipDeviceAttributeMultiprocessorCount, dev);
        if (hipFuncSetAttribute((const void*)mk_fwd, hipFuncAttributeMaxDynamicSharedMemorySize, LDS_BYTES) != hipSuccess) { fprintf(stderr, "kernel_launch: hipFuncSetAttribute failed\n"); grid = -1; return; }
        hipOccupancyMaxActiveBlocksPerMultiprocessor(&per_cu, (const void*)mk_fwd, NTHR, LDS_BYTES);
        if (per_cu < 1) { fprintf(stderr, "kernel_launch: occupancy query says %d blocks per CU\n", per_cu); per_cu = 1; }
        (void)hipGetLastError();
        grid = cus;
    }
    if (grid < 0) return;
    Args a{};
    for (int i = 0; i < 22; ++i) a.in[i] = (const float*)d_in[i];
    a.out = (float*)d_out; a.ws = (unsigned char*)d_ws;
#if MK_MULTI
    for (int p = 0; p < N_PHASES; ++p) {
        a.ph_lo = p; a.ph_hi = p + 1;
        void* args[] = {&a};
        hipError_t e = hipLaunchCooperativeKernel((const void*)mk_fwd, dim3(grid), dim3(NTHR), args, LDS_BYTES, stream);
        if (e != hipSuccess) { fprintf(stderr, "launch %d failed: %s\n", p, hipGetErrorString(e)); break; }
    }
#else
    a.ph_lo = 0; a.ph_hi = N_PHASES;
    void* args[] = {&a};
    hipError_t e = hipLaunchCooperativeKernel((const void*)mk_fwd, dim3(grid), dim3(NTHR), args, LDS_BYTES, stream);
    if (e != hipSuccess) fprintf(stderr, "cooperative launch failed: %s (grid %d)\n", hipGetErrorString(e), grid);
#endif
}
```
